# Optimizing an MI355X kernel written in HIP

```python
import jax, jax.numpy as jnp
from jax import lax
import numpy as np

D_MODEL = 2048
BATCH = 1
SEQ = 16384
DEPTH = 2

D_MIX = D_MODEL
HEAD_DIM = 128
ATT_HEADS = 8
ATT_W = ATT_HEADS * HEAD_DIM
CONV_GROUPS = 4
CONV_W = CONV_GROUPS * HEAD_DIM
SGU_HEADS = 4
SGU_W = SGU_HEADS * HEAD_DIM
CONV_K = 31
CHUNK = 128
Q_BLOCK = 128
PLE_DIM = 256
EPS = 1e-6
SPLIT_SIZES = (ATT_W, ATT_W, ATT_W, ATT_W, ATT_HEADS, CONV_W, CONV_W, CONV_W, SGU_W, SGU_W, SGU_W)
N_IN = 4 * ATT_W + ATT_HEADS + 3 * CONV_W + 3 * SGU_W

kernel_name = "hymba_style_conv_sgu_fox_hybrid"


def rmsnorm(x, g):
    xf = x.astype(jnp.float32)
    inv = lax.rsqrt(jnp.mean(xf * xf, axis=-1, keepdims=True) + EPS)
    return (xf * inv * g.astype(jnp.float32)).astype(x.dtype)


def layernorm(x, g, b):
    xf = x.astype(jnp.float32)
    mu = jnp.mean(xf, axis=-1, keepdims=True)
    var = jnp.mean(jnp.square(xf - mu), axis=-1, keepdims=True)
    y = (xf - mu) * lax.rsqrt(var + EPS) * g.astype(jnp.float32) + b.astype(jnp.float32)
    return y.astype(x.dtype)


def split_columns(proj):
    idx = np.cumsum(np.array(SPLIT_SIZES))[:-1].tolist()
    return jnp.split(proj, idx, axis=-1)


def conformer_conv(a, b, dw, dw_b, ln_g, ln_b, pw, pw_b):
    y = a * jax.nn.sigmoid(b)
    y = lax.conv_general_dilated(
        y, dw[:, None, :], window_strides=(1,), padding=[(CONV_K - 1, 0)],
        dimension_numbers=('NWC', 'WIO', 'NWC'), feature_group_count=CONV_W) + dw_b
    y = jax.nn.silu(layernorm(y, ln_g, ln_b))
    return y @ pw + pw_b


def spatial_gating(u, v, ln_g, ln_b, w_s, b_s):
    bsz, seq, _ = v.shape
    u = jax.nn.gelu(u, approximate=False)
    v = layernorm(jax.nn.gelu(v, approximate=False), ln_g, ln_b)
    v = v.reshape(bsz, seq // CHUNK, CHUNK, SGU_HEADS, HEAD_DIM)
    causal = jnp.tril(jnp.ones((CHUNK, CHUNK), dtype=bool))
    w = jnp.where(causal, w_s, 0)
    sv = jnp.einsum('hts,bnshd->bnthd', w, v) + b_s.T[:, :, None]
    return u * sv.reshape(bsz, seq, SGU_W)


def forgetting_attention(q, k, v, f_logit, b_f):
    bsz, seq, _ = q.shape
    q = q.reshape(bsz, seq, ATT_HEADS, HEAD_DIM) * (HEAD_DIM ** -0.5)
    k = k.reshape(bsz, seq, ATT_HEADS, HEAD_DIM)
    v = v.reshape(bsz, seq, ATT_HEADS, HEAD_DIM)
    log_f = jax.nn.log_sigmoid(f_logit.astype(jnp.float32) + b_f.astype(jnp.float32))
    c = jnp.cumsum(log_f, axis=1)
    c_k = jnp.transpose(c, (0, 2, 1))[:, :, None, :]
    key_pos = jnp.arange(seq)

    def block(i):
        start = i * Q_BLOCK
        qb = lax.dynamic_slice_in_dim(q, start, Q_BLOCK, axis=1)
        cq = lax.dynamic_slice_in_dim(c, start, Q_BLOCK, axis=1)
        s = jnp.einsum('bqhd,bkhd->bhqk', qb, k).astype(jnp.float32)
        s = s + (jnp.transpose(cq, (0, 2, 1))[:, :, :, None] - c_k)
        q_pos = start + jnp.arange(Q_BLOCK)
        mask = q_pos[:, None] >= key_pos[None, :]
        s = jnp.where(mask, s, -1e30)
        prob = jax.nn.softmax(s, axis=-1).astype(v.dtype)
        return jnp.einsum('bhqk,bkhd->bqhd', prob, v)

    out = lax.map(block, jnp.arange(seq // Q_BLOCK))
    return jnp.moveaxis(out, 0, 1).reshape(bsz, seq, ATT_W)


def setup_inputs(seed: int = 0) -> dict:
    key = jax.random.key(seed)
    ks = jax.random.split(key, 24)
    f32 = jnp.float32
    nrm = lambda k, shape, scale: jax.random.normal(k, shape, f32) * scale
    return {
        "x": nrm(ks[0], (BATCH, SEQ, D_MODEL), 1.0),
        "p": nrm(ks[1], (DEPTH, BATCH, SEQ, PLE_DIM), 1.0),
        "norm_pre": 1.0 + nrm(ks[2], (DEPTH, D_MODEL), 0.02),
        "w_in": nrm(ks[3], (DEPTH, D_MODEL, N_IN), D_MODEL ** -0.5),
        "b_f": jnp.broadcast_to(jnp.linspace(1.0, 6.0, ATT_HEADS, dtype=f32), (DEPTH, ATT_HEADS)) + nrm(ks[4], (DEPTH, ATT_HEADS), 0.1),
        "conv_dw": nrm(ks[5], (DEPTH, CONV_K, CONV_W), CONV_K ** -0.5),
        "conv_dw_b": nrm(ks[6], (DEPTH, CONV_W), 0.01),
        "conv_ln_g": 1.0 + nrm(ks[7], (DEPTH, CONV_W), 0.02),
        "conv_ln_b": nrm(ks[8], (DEPTH, CONV_W), 0.01),
        "conv_pw": nrm(ks[9], (DEPTH, CONV_W, CONV_W), CONV_W ** -0.5),
        "conv_pw_b": nrm(ks[10], (DEPTH, CONV_W), 0.01),
        "sgu_ln_g": 1.0 + nrm(ks[11], (DEPTH, SGU_W), 0.02),
        "sgu_ln_b": nrm(ks[12], (DEPTH, SGU_W), 0.01),
        "sgu_w": nrm(ks[13], (DEPTH, SGU_HEADS, CHUNK, CHUNK), CHUNK ** -0.5),
        "sgu_b": 1.0 + nrm(ks[14], (DEPTH, SGU_HEADS, CHUNK), 0.01),
        "w_out": nrm(ks[15], (DEPTH, D_MIX, D_MODEL), D_MIX ** -0.5),
        "norm_post": 1.0 + nrm(ks[16], (DEPTH, D_MODEL), 0.02),
        "w_pg": nrm(ks[17], (DEPTH, D_MODEL, D_MODEL), D_MODEL ** -0.5),
        "w_pp": nrm(ks[18], (DEPTH, PLE_DIM, D_MODEL), PLE_DIM ** -0.5),
    }


def reference(x, p, norm_pre, w_in, b_f, conv_dw, conv_dw_b, conv_ln_g, conv_ln_b, conv_pw, conv_pw_b,
              sgu_ln_g, sgu_ln_b, sgu_w, sgu_b, w_out, norm_post, w_pg, w_pp):
    h = x
    for i in range(DEPTH):
        xn = rmsnorm(h, norm_pre[i])
        proj = xn @ w_in[i]
        (q, k, v, z_att, f_logit, glu_a, glu_b, z_conv, u_sgu, v_sgu, z_sgu) = split_columns(proj)
        y_conv = conformer_conv(glu_a, glu_b, conv_dw[i], conv_dw_b[i], conv_ln_g[i], conv_ln_b[i],
                                conv_pw[i], conv_pw_b[i]) * jax.nn.silu(z_conv)
        y_sgu = spatial_gating(u_sgu, v_sgu, sgu_ln_g[i], sgu_ln_b[i], sgu_w[i], sgu_b[i]) * jax.nn.silu(z_sgu)
        y_att = forgetting_attention(q, k, v, f_logit, b_f[i]) * jax.nn.silu(z_att)
        y = jnp.concatenate([y_conv, y_sgu, y_att], axis=-1) @ w_out[i]
        h = h + rmsnorm(y, norm_post[i])
        h = h + jax.nn.sigmoid(h @ w_pg[i]) * (p[i] @ w_pp[i])
    return h
```

```cpp
#include <hip/hip_runtime.h>
#include <hip/hip_cooperative_groups.h>
#include <hip/hip_bf16.h>
#include <cstdio>
#include <cstdint>
namespace cg = cooperative_groups;

#ifndef MK_COOP
#define MK_COOP 1
#endif

#ifndef DUP_ATT
#define DUP_ATT 1
#endif
#ifndef DUP_INPROJ
#define DUP_INPROJ 1
#endif
#ifndef DUP_CS
#define DUP_CS 1
#endif
#ifndef DUP_SGU
#define DUP_SGU 1
#endif
#ifndef DUP_OUT
#define DUP_OUT 1
#endif
#ifndef DUP_ROWS
#define DUP_ROWS 1
#endif
#ifndef DUP_PREP
#define DUP_PREP 1
#endif
#ifndef DUP_NORM
#define DUP_NORM 1
#endif
#ifndef DUP_LIST
#define DUP_LIST 1
#endif
#ifndef DUP_CMB
#define DUP_CMB 1
#endif
#define LAS __attribute__((address_space(3)))
typedef unsigned short bf16_t;
typedef short bf16x8 __attribute__((ext_vector_type(8)));
typedef short s16x4 __attribute__((ext_vector_type(4)));
typedef float f32x4 __attribute__((ext_vector_type(4)));
typedef float f32x2 __attribute__((ext_vector_type(2)));
typedef float f32x16 __attribute__((ext_vector_type(16)));
typedef unsigned u32x4 __attribute__((ext_vector_type(4)));
typedef unsigned u32x2 __attribute__((ext_vector_type(2)));

constexpr int S = 16384, DM = 2048, NIN = 7176, NP = 7168, DEPTH = 2, PLE = 256;
constexpr int C_Q = 0, C_K = 1024, C_V = 2048, C_ZA = 3072, C_GA = 4096, C_GB = 4608, C_ZC = 5120, C_U = 5632, C_VS = 6144, C_ZS = 6656;
constexpr float EPS = 1e-6f;
constexpr int NWAVES = 8, NTHR = 512;
constexpr size_t SZ_WIN = (size_t)NP * DM * 2, SZ_WSQ = (size_t)DM * DM * 2, SZ_WPP = (size_t)DM * PLE * 2, SZ_WPW = 512 * 512 * 2, SZ_SW = 4 * 128 * 128 * 2;
constexpr size_t WS_WIN = 0;
constexpr size_t WS_WOUT = WS_WIN + DEPTH * SZ_WIN;
constexpr size_t WS_WPG = WS_WOUT + DEPTH * SZ_WSQ;
constexpr size_t WS_WPP = WS_WPG + DEPTH * SZ_WSQ;
constexpr size_t WS_WPW = WS_WPP + DEPTH * SZ_WPP;
constexpr size_t WS_SW = WS_WPW + DEPTH * SZ_WPW;
constexpr size_t WS_PB = WS_SW + DEPTH * SZ_SW;
constexpr size_t WS_FL = WS_PB + (size_t)DEPTH * S * PLE * 2;
constexpr size_t WS_CS = WS_FL + (size_t)S * 8 * 4;
constexpr size_t WS_YCAT = WS_CS + (size_t)S * 8 * 4;
constexpr size_t WS_PROJ = WS_YCAT + (size_t)S * DM * 2;
constexpr size_t WS_Y = WS_PROJ;
constexpr size_t WS_PBUF = WS_PROJ + (size_t)S * DM * 4;
constexpr size_t WS_CTL = WS_PROJ + (size_t)S * NP * 2;
constexpr size_t CTL_BYTES = 65536;
constexpr size_t WS_XN = WS_CTL + CTL_BYTES;
constexpr int PART_SLOTS = 1792, PART_STRIDE = 8 * 2048 + 8 * 64;
constexpr size_t WS_PART = WS_XN;
constexpr size_t SZ_PART = (size_t)PART_SLOTS * PART_STRIDE * 4;
constexpr size_t WS_END = WS_XN + (SZ_PART > (size_t)S * DM * 2 ? SZ_PART : (size_t)S * DM * 2);
static_assert(WS_PBUF + (size_t)S * DM * 2 <= WS_CTL, "overlay");

static_assert(WS_END <= (size_t)512 * 1024 * 1024, "ws");
constexpr int LDS_BYTES = 136192, MISC_OFF = 132096;

__device__ __forceinline__ unsigned f2bf(float f) { unsigned u = __builtin_bit_cast(unsigned, f); return (u + 0x7fffu + ((u >> 16) & 1u)) >> 16; }
__device__ __forceinline__ unsigned pk2(float lo, float hi) { return f2bf(lo) | (f2bf(hi) << 16); }
__device__ __forceinline__ float bf2f(bf16_t b) { return __builtin_bit_cast(float, (unsigned)b << 16); }
__device__ __forceinline__ float bflo(unsigned w) { return __builtin_bit_cast(float, w << 16); }
__device__ __forceinline__ float bfhi(unsigned w) { return __builtin_bit_cast(float, w & 0xffff0000u); }
__device__ __forceinline__ unsigned cvt_pk_bf16(float lo, float hi) { unsigned r; asm volatile("v_cvt_pk_bf16_f32 %0, %1, %2" : "=v"(r) : "v"(lo), "v"(hi)); return r; }
__device__ __forceinline__ int otid() { int t = threadIdx.x; asm volatile("" : "+v"(t)); return t; }
__device__ __forceinline__ float wave_sum(float v) {
    v += __builtin_bit_cast(float, __builtin_amdgcn_update_dpp(0, __builtin_bit_cast(int, v), 0xB1, 0xF, 0xF, true));
    v += __builtin_bit_cast(float, __builtin_amdgcn_update_dpp(0, __builtin_bit_cast(int, v), 0x4E, 0xF, 0xF, true));
    v += __builtin_bit_cast(float, __builtin_amdgcn_update_dpp(0, __builtin_bit_cast(int, v), 0x141, 0xF, 0xF, true));
    v += __builtin_bit_cast(float, __builtin_amdgcn_update_dpp(0, __builtin_bit_cast(int, v), 0x140, 0xF, 0xF, true));
    { auto rr = __builtin_amdgcn_permlane16_swap(__float_as_uint(v), __float_as_uint(v), false, false); v = __uint_as_float(rr[0]) + __uint_as_float(rr[1]); }
    { auto rr = __builtin_amdgcn_permlane32_swap(__float_as_uint(v), __float_as_uint(v), false, false); v = __uint_as_float(rr[0]) + __uint_as_float(rr[1]); }
    return v;
}
__device__ __forceinline__ float sigmoid_f(float x) { return __builtin_amdgcn_rcpf(1.f + __builtin_amdgcn_exp2f(-1.4426950408889634f * x)); }
__device__ __forceinline__ float silu_f(float x) { return x * sigmoid_f(x); }
__device__ __forceinline__ float gelu_f(float v) {
    const float av = __builtin_fabsf(v), d = av * 0.2316418882f + 1.0f, t = __builtin_amdgcn_rcpf(d);
    float q = t * 0.5307027145f + (-0.7265760135f); q = q * t + 0.7107068705f; q = q * t + (-0.142248368f); q = q * t + 0.127414796f; q = q * t;
    const float e = __builtin_amdgcn_exp2f((v * v) * (-0.72134752044f));
    const float m = v * (q * e);
    return v < 0.f ? m : v - m;
}

namespace pg8 {
constexpr int BM = 256, BK = 64, HALF = 128, HTB = HALF * BK * 2, STAGE_BYTES = 8 * HTB, NXCD = 8, WGM = 8;
__host__ __device__ __forceinline__ int lds_byte(int r, int c) { const int st = (r >> 4) * 2 + (c >> 5), rr = r & 15, cc = c & 31, ob = rr * 64 + cc * 2; return st * 1024 + (ob ^ (((ob >> 9) & 1) << 5)); }
__host__ __device__ __forceinline__ void stage_rc(int b, int& R, int& C) { const int st = b / 1024, sb = b % 1024, swz = sb ^ (((sb >> 9) & 1) << 5); R = (st >> 1) * 16 + swz / 64; C = (st & 1) * 32 + (swz % 64) / 2; }
__host__ __device__ __forceinline__ int perm32(int rho) { const int n = rho >> 4, i = rho & 15; return 8 * (i >> 2) + 4 * n + (i & 3); }
struct Unit { int pm, pn; };
struct Gemm { const bf16_t* A; const bf16_t* Bt; int M, N, K; };
struct StaticOrder {
    int nM, nN, nwg, G, c;
    __host__ __device__ void init(int M, int N, int G_, int c_) { nM = M / BM; nN = N / BM; nwg = nM * nN; G = G_; c = c_; }
    __host__ __device__ bool next(int i, Unit& u) const {
        const long L = (long)i * G + c; if (L >= nwg) return false;
        int wgid = (int)L; { const int q = nwg / NXCD, r = nwg % NXCD, xcd = wgid % NXCD, off = wgid / NXCD; wgid = (xcd < r ? xcd * (q + 1) : r * (q + 1) + (xcd - r) * q) + off; }
        const int nig = WGM * nN, gid = wgid / nig, fm = gid * WGM, gsz = (nM - fm) < WGM ? (nM - fm) : WGM;
        u.pm = fm + ((wgid % nig) % gsz); u.pn = (wgid % nig) / gsz; return true;
    }
};
__device__ __forceinline__ float act_f(float x, int act) { return act == 1 ? silu_f(x) : act == 2 ? sigmoid_f(x) : gelu_f(x); }
template <bool ACTS> struct EpiBf16T {
    static constexpr bool PERM = true;
    bf16_t* O; int ldc;
    __device__ __forceinline__ void operator()(const f32x4 (&acc)[2][2][4][2], const Unit& u, int wr, int wc, int fr, int fq) const {
        const int row0 = u.pm * BM + wr * 64 + fr; const int col0 = u.pn * BM + wc * 32 + 8 * fq;
        const int pn = u.pn; const int act = !ACTS ? 0 : (pn < 12 ? 0 : pn < 16 ? 1 : pn < 18 ? 0 : pn < 20 ? 2 : pn < 22 ? 1 : pn < 26 ? 3 : 1);
        asm volatile("s_nop 15\n\ts_nop 15" ::: "memory");
#pragma unroll
        for (int ai = 0; ai < 2; ++ai)
#pragma unroll
            for (int m = 0; m < 4; ++m) { bf16_t* rowp = O + (size_t)(row0 + ai * HALF + m * 16) * ldc + col0;
#pragma unroll
                for (int bj = 0; bj < 2; ++bj) { f32x4 v0 = acc[ai][bj][m][0], v1 = acc[ai][bj][m][1];
                    if (ACTS && act != 0) {
#pragma unroll
                        for (int e = 0; e < 4; ++e) { v0[e] = act_f(v0[e], act); v1[e] = act_f(v1[e], act); } }
                    u32x4 w; w.x = cvt_pk_bf16(v0[0], v0[1]); w.y = cvt_pk_bf16(v0[2], v0[3]); w.z = cvt_pk_bf16(v1[0], v1[1]); w.w = cvt_pk_bf16(v1[2], v1[3]);
                    *(u32x4*)(rowp + bj * HALF) = w; } }
    }
};
typedef EpiBf16T<false> EpiBf16;
typedef EpiBf16T<true> EpiBf16Act;
struct EpiF32 {
    static constexpr bool PERM = false;
    float* O; int ldc;
    __device__ __forceinline__ void operator()(const f32x4 (&acc)[2][2][4][2], const Unit& u, int wr, int wc, int fr, int fq) const {
        const int col0 = u.pn * BM + wc * 32 + 4 * fq;
#pragma unroll
        for (int ai = 0; ai < 2; ++ai)
#pragma unroll
            for (int m = 0; m < 4; ++m) { const size_t off = (size_t)(u.pm * BM + ai * HALF + wr * 64 + m * 16 + fr) * ldc + col0;
#pragma unroll
                for (int bj = 0; bj < 2; ++bj)
#pragma unroll
                    for (int n = 0; n < 2; ++n) *(f32x4*)(O + off + bj * HALF + n * 16) = acc[ai][bj][m][n]; }
    }
};
struct EpiPle {
    static constexpr bool PERM = false;
    float* H; const bf16_t* P; int ldc;
    __device__ __forceinline__ void operator()(const f32x4 (&acc)[2][2][4][2], const Unit& u, int wr, int wc, int fr, int fq) const {
        const int col0 = u.pn * BM + wc * 32 + 4 * fq;
#pragma unroll
        for (int ai = 0; ai < 2; ++ai)
#pragma unroll
            for (int mp = 0; mp < 4; mp += 2) {
                f32x4 hh[2][2][2]; u32x2 pp[2][2][2];
#pragma unroll
                for (int mm = 0; mm < 2; ++mm) { const size_t off = (size_t)(u.pm * BM + ai * HALF + wr * 64 + (mp + mm) * 16 + fr) * ldc + col0;
#pragma unroll
                    for (int bj = 0; bj < 2; ++bj)
#pragma unroll
                        for (int n = 0; n < 2; ++n) { const size_t o2 = off + bj * HALF + n * 16; hh[mm][bj][n] = *(const f32x4*)(H + o2); pp[mm][bj][n] = *(const u32x2*)(P + o2); } }
#pragma unroll
                for (int mm = 0; mm < 2; ++mm) { const size_t off = (size_t)(u.pm * BM + ai * HALF + wr * 64 + (mp + mm) * 16 + fr) * ldc + col0;
#pragma unroll
                    for (int bj = 0; bj < 2; ++bj)
#pragma unroll
                        for (int n = 0; n < 2; ++n) { const size_t o2 = off + bj * HALF + n * 16; const f32x4 g = acc[ai][bj][mp + mm][n]; const f32x4 h = hh[mm][bj][n]; const u32x2 pw = pp[mm][bj][n];
                            f32x4 r; r[0] = h[0] + sigmoid_f(g[0]) * bflo(pw.x); r[1] = h[1] + sigmoid_f(g[1]) * bfhi(pw.x); r[2] = h[2] + sigmoid_f(g[2]) * bflo(pw.y); r[3] = h[3] + sigmoid_f(g[3]) * bfhi(pw.y);
                            *(f32x4*)(H + o2) = r; } }
            }
    }
};

template <class Epi>
__device__ __forceinline__ void gemm_phase(LAS unsigned char* lds, const Gemm g, const StaticOrder& S_, const Epi& E) {
    const int tid = otid(), wid = __builtin_amdgcn_readfirstlane(tid >> 6), lane = tid & 63, wr = wid >> 2, wc = wid & 3, fr = lane & 15, fq = lane >> 4;
    const int K = g.K, nt = K / BK;
    unsigned voffA[2], voffB[2];
#pragma unroll
    for (int i = 0; i < 2; ++i) { int R, C; stage_rc(tid * 16 + i * 8192, R, C); const int Rb = Epi::PERM ? ((R & ~31) + perm32(R & 31)) : R;
        voffA[i] = (unsigned)(R * K + C) * 2u; voffB[i] = (unsigned)(Rb * K + C) * 2u; }
    const size_t kstep = (size_t)(BK * 2);
    const size_t hstep = (size_t)HALF * K * 2;
    const size_t tstep = 2 * hstep;
    const unsigned ldsw = (unsigned)wid * 1024u;
    const int aoff = lds_byte(wr * 64 + fr, fq * 8), boff = lds_byte(wc * 32 + fr, fq * 8);
#define PG8_SA(b, h) (((b) * 2 + (h)) * HTB)
#define PG8_SB(b, h) ((4 + (b) * 2 + (h)) * HTB)
#define PG8_STAGE(bufoff, gbase, voff) do { _Pragma("unroll") for (int _i = 0; _i < 2; ++_i) \
        __builtin_amdgcn_global_load_lds((const unsigned*)((const char*)(gbase) + (voff)[_i]), (LAS unsigned*)(lds + (bufoff) + ldsw + _i * 8192), 16, 0, 0); } while (0)
#define PG8_LDA(dst, b, h) do { _Pragma("unroll") for (int m = 0; m < 4; ++m) _Pragma("unroll") for (int k = 0; k < 2; ++k) dst[m][k] = *(const LAS bf16x8*)(lds + PG8_SA(b, h) + aoff + m * 2048 + k * 1024); } while (0)
#define PG8_LDB(dst, b, h) do { _Pragma("unroll") for (int n = 0; n < 2; ++n) _Pragma("unroll") for (int k = 0; k < 2; ++k) dst[n][k] = *(const LAS bf16x8*)(lds + PG8_SB(b, h) + boff + n * 2048 + k * 1024); } while (0)
#define PG8_MMA(ai, bj, At, Bt) do { __builtin_amdgcn_s_setprio(1); _Pragma("unroll") for (int m = 0; m < 4; ++m) _Pragma("unroll") for (int n = 0; n < 2; ++n) _Pragma("unroll") for (int k = 0; k < 2; ++k) \
        acc[ai][bj][m][n] = __builtin_amdgcn_mfma_f32_16x16x32_bf16(Bt[n][k], At[m][k], acc[ai][bj][m][n], 0, 0, 0); __builtin_amdgcn_s_setprio(0); } while (0)
#define PG8_WAIT_V(n) asm volatile("s_waitcnt vmcnt(" #n ")" ::: "memory")
#define PG8_WAIT_L(n) asm volatile("s_waitcnt lgkmcnt(" #n ")" ::: "memory")
#define PG8_BAR __builtin_amdgcn_s_barrier()
#define PG8_SCHED __builtin_amdgcn_sched_barrier(0)
    Unit cur, nxt; int ui = 0;
    if (!S_.next(0, cur)) return;
    f32x4 acc[2][2][4][2];
#pragma unroll
    for (int a = 0; a < 2; ++a)
#pragma unroll
        for (int b = 0; b < 2; ++b)
#pragma unroll
            for (int m = 0; m < 4; ++m)
#pragma unroll
                for (int n = 0; n < 2; ++n) acc[a][b][m][n] = (f32x4){0.f, 0.f, 0.f, 0.f};
    bf16x8 At[4][2], B0[2][2], B1[2][2];
    const char* cA = (const char*)g.A + (size_t)cur.pm * tstep; const char* cB = (const char*)g.Bt + (size_t)cur.pn * tstep;
    PG8_STAGE(PG8_SB(0, 0), cB, voffB); PG8_STAGE(PG8_SB(0, 1), cB + hstep, voffB); PG8_STAGE(PG8_SA(0, 0), cA, voffA); PG8_STAGE(PG8_SA(0, 1), cA + hstep, voffA);
    if (wr == 1) PG8_BAR;
    PG8_WAIT_V(2); PG8_BAR;
    PG8_STAGE(PG8_SB(1, 0), cB + kstep, voffB); PG8_STAGE(PG8_SA(1, 0), cA + kstep, voffA); PG8_STAGE(PG8_SB(1, 1), cB + hstep + kstep, voffB);
    PG8_WAIT_V(6); PG8_BAR;
    for (;;) {
        const bool has_next = S_.next(ui + 1, nxt);
        const char* nA = has_next ? (const char*)g.A + (size_t)nxt.pm * tstep : cA; const char* nB = has_next ? (const char*)g.Bt + (size_t)nxt.pn * tstep : cB;
        for (int t = 0; t < nt; t += 2) {
            const bool last = (t == nt - 2);
            const char* a1 = cA + (size_t)(t + 1) * kstep;
            const char* a2 = last ? nA : cA + (size_t)(t + 2) * kstep; const char* b2 = last ? nB : cB + (size_t)(t + 2) * kstep;
            const char* a3 = a2 + kstep; const char* b3 = b2 + kstep;
            PG8_LDB(B0, 0, 0); PG8_LDB(B1, 0, 1); PG8_SCHED; PG8_LDA(At, 0, 0); PG8_STAGE(PG8_SA(1, 1), a1 + hstep, voffA);
            PG8_WAIT_V(8); PG8_WAIT_L(0); PG8_BAR; PG8_MMA(0, 0, At, B0); PG8_MMA(0, 1, At, B1); PG8_BAR; PG8_SCHED;
            PG8_LDA(At, 0, 1); PG8_STAGE(PG8_SB(0, 0), b2, voffB); PG8_STAGE(PG8_SB(0, 1), b2 + hstep, voffB); PG8_STAGE(PG8_SA(0, 0), a2, voffA);
            PG8_WAIT_V(8); PG8_WAIT_L(0); PG8_BAR; PG8_MMA(1, 0, At, B0); PG8_MMA(1, 1, At, B1); PG8_BAR; PG8_SCHED;
            PG8_LDB(B0, 1, 0); PG8_LDB(B1, 1, 1); PG8_SCHED; PG8_LDA(At, 1, 0); PG8_STAGE(PG8_SA(0, 1), a2 + hstep, voffA);
            PG8_WAIT_V(8); PG8_WAIT_L(0); PG8_BAR; PG8_MMA(0, 0, At, B0); PG8_MMA(0, 1, At, B1); PG8_BAR; PG8_SCHED;
            PG8_LDA(At, 1, 1); PG8_STAGE(PG8_SB(1, 0), b3, voffB); PG8_STAGE(PG8_SB(1, 1), b3 + hstep, voffB); PG8_STAGE(PG8_SA(1, 0), a3, voffA);
            PG8_WAIT_V(8); PG8_WAIT_L(0); PG8_BAR; PG8_MMA(1, 0, At, B0); PG8_MMA(1, 1, At, B1); PG8_BAR; PG8_SCHED;
        }
        if (wr == 0) PG8_BAR;
        E(acc, cur, wr, wc, fr, fq);
        if (!has_next) break;
#pragma unroll
        for (int a = 0; a < 2; ++a)
#pragma unroll
            for (int b = 0; b < 2; ++b)
#pragma unroll
                for (int m = 0; m < 4; ++m)
#pragma unroll
                    for (int n = 0; n < 2; ++n) acc[a][b][m][n] = (f32x4){0.f, 0.f, 0.f, 0.f};
        cur = nxt; cA = nA; cB = nB; ++ui;
        if (wr == 1) PG8_BAR;
    }
    PG8_WAIT_V(0);
    PG8_BAR;
#undef PG8_SA
#undef PG8_SB
#undef PG8_STAGE
#undef PG8_LDA
#undef PG8_LDB
#undef PG8_MMA
#undef PG8_WAIT_V
#undef PG8_WAIT_L
#undef PG8_BAR
#undef PG8_SCHED
}
}

namespace fox {
constexpr int D = 128, NW = 8, QBLK = 32, KVBLK = 64, QB = NW * QBLK;
constexpr int SHM_V = KVBLK * D * 2, SHM_K = KVBLK * D * 2;
constexpr int CB_OFF = 2 * SHM_V + 2 * SHM_K + NW * 64 * 4;
constexpr int ATT_LDS = CB_OFF + 512;
constexpr int LDK = NP;
constexpr int LDO = DM;
constexpr float SCALE = 0.08838834764831845f;
constexpr float THR = 8.f;
#define KSWZ(row, colB) ((row) * 256 + ((colB) ^ (((row) & 7) << 4)))
#define SBAR() __builtin_amdgcn_sched_barrier(0)
__device__ __forceinline__ int v_st(int k, int c) { const int kk = (k & ~0xC) | ((k & 4) << 1) | ((k & 8) >> 1); return ((kk >> 3) * 4 + (c >> 5)) * 512 + ((kk & 7) * 32 + (c & 31)) * 2; }
__device__ __forceinline__ int v_rd_base(int lane) { return ((lane & 3) << 3) | (((lane >> 2) & 3) << 6) | (((lane >> 4) & 1) << 5) | (((lane >> 5) & 1) << 8); }
constexpr int v_rd_off(int d0, int ks, int half) { return d0 * 512 + ks * 4096 + half * 2048; }
__device__ __forceinline__ int crow(int r, int hi) { return (r & 3) + 8 * (r >> 2) + 4 * hi; }
__device__ __forceinline__ unsigned cvtpk(float lo, float hi) { unsigned r; asm volatile("v_cvt_pk_bf16_f32 %0, %1, %2" : "=v"(r) : "v"(lo), "v"(hi)); return r; }
__device__ __forceinline__ bf16x8 load8(const bf16_t* p) { return *reinterpret_cast<const bf16x8*>(p); }
__device__ __forceinline__ void mask_tile(f32x16& p0, f32x16& p1, int dq) {
    const float NEG = -__builtin_inff();
#pragma unroll
    for (int r = 0; r < 16; ++r) {
        const int c = (r & 3) + 8 * (r >> 2);
        if (dq - c < 0) p0[r] = NEG;
        if (dq - c - 32 < 0) p1[r] = NEG;
    }
}
__device__ __forceinline__ void partialSM(f32x16& p0, f32x16& p1, float& m_reg, float& mn, float& alpha) {
    float pmax = p0[0];
#pragma unroll
    for (int r = 1; r < 16; ++r) pmax = fmaxf(pmax, p0[r]);
#pragma unroll
    for (int r = 0; r < 16; ++r) pmax = fmaxf(pmax, p1[r]);
    { auto rr = __builtin_amdgcn_permlane32_swap(__float_as_uint(pmax), __float_as_uint(pmax), false, false);
      pmax = fmaxf(__uint_as_float(rr[0]), __uint_as_float(rr[1])); }
    constexpr float C2 = 1.4426950408889634f * SCALE;
    if (__builtin_expect(__all((pmax - m_reg) * SCALE <= THR), 1)) { mn = m_reg; alpha = 1.f; }
    else { mn = fmaxf(m_reg, pmax); alpha = __builtin_amdgcn_exp2f((m_reg - mn) * C2); m_reg = mn; }
    const float mnL = -mn * C2;
#pragma unroll
    for (int r = 0; r < 16; ++r) p0[r] = fmaf(p0[r], C2, mnL);
#pragma unroll
    for (int r = 0; r < 16; ++r) p1[r] = fmaf(p1[r], C2, mnL);
#pragma unroll
    for (int r = 0; r < 16; ++r) p0[r] = __builtin_amdgcn_exp2f(p0[r]);
}
__device__ __forceinline__ void finishSM(f32x16& p0, f32x16& p1, float alpha, float& l_reg, bf16x8& pa0, bf16x8& pa1, bf16x8& pa2, bf16x8& pa3) {
#pragma unroll
    for (int r = 0; r < 16; ++r) p1[r] = __builtin_amdgcn_exp2f(p1[r]);
    float ps = 0;
#pragma unroll
    for (int r = 0; r < 16; ++r) ps += p0[r];
#pragma unroll
    for (int r = 0; r < 16; ++r) ps += p1[r];
    { auto rr = __builtin_amdgcn_permlane32_swap(__float_as_uint(ps), __float_as_uint(ps), false, false);
      ps = __uint_as_float(rr[0]) + __uint_as_float(rr[1]); }
    l_reg = l_reg * alpha + ps;
#define PK4(P, B_, OUT) do { unsigned a0 = cvtpk(P[B_+0], P[B_+1]), a1 = cvtpk(P[B_+2], P[B_+3]);                          \
        unsigned b0 = cvtpk(P[B_+4], P[B_+5]), b1 = cvtpk(P[B_+6], P[B_+7]);                                             \
        auto r0 = __builtin_amdgcn_permlane32_swap(a0, b0, false, false); auto r1 = __builtin_amdgcn_permlane32_swap(a1, b1, false, false); \
        u32x4 w = {r0[0], r1[0], r0[1], r1[1]}; OUT = *reinterpret_cast<bf16x8*>(&w); } while (0)
    PK4(p0, 0, pa0); PK4(p0, 8, pa1); PK4(p1, 0, pa2); PK4(p1, 8, pa3);
#undef PK4
}
template <int KB>
__device__ __forceinline__ void qkt(f32x16& p0, f32x16& p1, const char* K_lds, int r32, int hi, const bf16x8* qr, float cq, const LAS float* cbp) {
    {   const LAS float* c_ = cbp + KB * 64;
        const f32x4 a0 = *(const LAS f32x4*)(c_), a1 = *(const LAS f32x4*)(c_ + 8), a2 = *(const LAS f32x4*)(c_ + 16), a3 = *(const LAS f32x4*)(c_ + 24);
        const f32x4 b0 = *(const LAS f32x4*)(c_ + 32), b1 = *(const LAS f32x4*)(c_ + 40), b2 = *(const LAS f32x4*)(c_ + 48), b3 = *(const LAS f32x4*)(c_ + 56);
#pragma unroll
        for (int e = 0; e < 4; ++e) { p0[e] = cq - a0[e]; p0[4 + e] = cq - a1[e]; p0[8 + e] = cq - a2[e]; p0[12 + e] = cq - a3[e];
                                      p1[e] = cq - b0[e]; p1[4 + e] = cq - b1[e]; p1[8 + e] = cq - b2[e]; p1[12 + e] = cq - b3[e]; } }
    const char* kb[4];
#pragma unroll
    for (int dd = 0; dd < 4; ++dd) kb[dd] = K_lds + KB * SHM_K + KSWZ(r32, (dd * 16 + hi * 8) * 2);
#pragma unroll
    for (int d0 = 0; d0 < 8; ++d0) { const char* a = kb[d0 & 3] + (d0 >> 2) * 128;
        bf16x8 b0 = *reinterpret_cast<const bf16x8*>(a);
        bf16x8 b1 = *reinterpret_cast<const bf16x8*>(a + 32 * 256);
        p0 = __builtin_amdgcn_mfma_f32_32x32x16_bf16(b0, qr[d0], p0, 0, 0, 0);
        p1 = __builtin_amdgcn_mfma_f32_32x32x16_bf16(b1, qr[d0], p1, 0, 0, 0); }
}
template <int VB>
__device__ __forceinline__ void pv_tile(f32x16* o, int vb0, bf16x8 pa0, bf16x8 pa1, bf16x8 pa2, bf16x8 pa3) {
#define TRRD(dst, off) asm volatile("ds_read_b64_tr_b16 %0, %1 offset:%2" : "=&v"(dst) : "v"(vb0), "i"(off) : "memory")
#define PV_D0(d0) do { s16x4 l0, l1, l2, l3, h0, h1, h2, h3; constexpr int b_ = VB * SHM_V + v_rd_off(d0, 0, 0); \
        TRRD(l0, b_); TRRD(h0, b_ + 2048); TRRD(l1, b_ + 4096); TRRD(h1, b_ + 6144); TRRD(l2, b_ + 8192); TRRD(h2, b_ + 10240); TRRD(l3, b_ + 12288); TRRD(h3, b_ + 14336); \
        asm volatile("s_waitcnt lgkmcnt(0)" ::: "memory"); SBAR();   \
        o[d0] = __builtin_amdgcn_mfma_f32_32x32x16_bf16(pa0, (bf16x8){l0[0], l0[1], l0[2], l0[3], h0[0], h0[1], h0[2], h0[3]}, o[d0], 0, 0, 0);   \
        o[d0] = __builtin_amdgcn_mfma_f32_32x32x16_bf16(pa1, (bf16x8){l1[0], l1[1], l1[2], l1[3], h1[0], h1[1], h1[2], h1[3]}, o[d0], 0, 0, 0);   \
        o[d0] = __builtin_amdgcn_mfma_f32_32x32x16_bf16(pa2, (bf16x8){l2[0], l2[1], l2[2], l2[3], h2[0], h2[1], h2[2], h2[3]}, o[d0], 0, 0, 0);   \
        o[d0] = __builtin_amdgcn_mfma_f32_32x32x16_bf16(pa3, (bf16x8){l3[0], l3[1], l3[2], l3[3], h3[0], h3[1], h3[2], h3[3]}, o[d0], 0, 0, 0); } while (0)
    PV_D0(0); PV_D0(1); PV_D0(2); PV_D0(3);
#undef PV_D0
#undef TRRD
}
struct BlockRef { int hd, P0, t_lo, NT, slot, direct; };
struct Bases { const bf16_t* PROJ; const float* CS; bf16_t* YCAT; float* PART; };
struct Seam { bf16x8 qr[8]; bf16x8 st_v0, st_v1, st_k0, st_k1; };
typedef __amdgpu_buffer_rsrc_t rsrc_t;
__device__ __forceinline__ rsrc_t mk_rsrc(const void* p, unsigned bytes) { return __builtin_amdgcn_make_buffer_rsrc((void*)p, 0, (int)bytes, 0x00020000); }
__device__ __forceinline__ bf16x8 bl_h8(rsrc_t r, unsigned vo, int so) { return __builtin_bit_cast(bf16x8, __builtin_amdgcn_raw_buffer_load_b128(r, (int)vo, so, 0)); }
__device__ __forceinline__ f32x4 bl_f4(rsrc_t r, unsigned vo, int so) { return __builtin_bit_cast(f32x4, __builtin_amdgcn_raw_buffer_load_b128(r, (int)vo, so, 0)); }
__device__ __forceinline__ float bl_f1(rsrc_t r, unsigned vo, int so) { return __builtin_bit_cast(float, __builtin_amdgcn_raw_buffer_load_b32(r, (int)vo, so, 0)); }
__device__ __forceinline__ bf16_t bl_h1(rsrc_t r, unsigned vo, int so) { return (bf16_t)__builtin_amdgcn_raw_buffer_load_b16(r, (int)vo, so, 0); }
#define VMW() asm volatile("s_waitcnt vmcnt(0)" ::: "memory")
#define VMWN(n) asm volatile("s_waitcnt vmcnt(%0)" :: "i"(n) : "memory")
#define SLOAD_K(hd_, k0) do { const int so_ = ((k0) * LDK + (hd_) * 128) * 2;                     \
                         S.st_k0 = bl_h8(rP, toffb, so_ + C_K * 2); S.st_k1 = bl_h8(rP, toffb, so_ + (C_K + 32 * LDK) * 2); } while (0)
#define SLOAD_V(hd_, k0) do { const int so_ = ((k0) * LDK + (hd_) * 128) * 2;                     \
                         S.st_v0 = bl_h8(rP, toffb, so_ + C_V * 2); S.st_v1 = bl_h8(rP, toffb, so_ + (C_V + 32 * LDK) * 2); } while (0)
#define SLOAD_H(hd_, k0) do { SLOAD_K(hd_, k0); SLOAD_V(hd_, k0); } while (0)
#define SWRITE_HK(bf) do { *(bf16x8*)(K_lds + (bf) * SHM_K + kws) = S.st_k0; *(bf16x8*)(K_lds + (bf) * SHM_K + kws + 32 * 256) = S.st_k1; } while (0)
#define SWRITE_HV(bf) do { *(bf16x8*)(V_lds + (bf) * SHM_V + vst0) = S.st_v0; *(bf16x8*)(V_lds + (bf) * SHM_V + vst1) = S.st_v1; } while (0)
#define SWRITE_H(bf) do { SWRITE_HV(bf); SWRITE_HK(bf); } while (0)
#define DMACK(hd_, t, bf) do { if (wid == 0) __builtin_amdgcn_global_load_lds((const unsigned*)(B.CS + (size_t)(hd_) * ::S + (t) * KVBLK + lane), (LAS unsigned*)(lds3 + CB_OFF + (bf) * 256), 4, 0, 0); } while (0)
__device__ __forceinline__ void fox_prime(const Bases& B, const BlockRef& cur, char* lds, LAS unsigned char* lds3, Seam& S) {
    const int tid = otid(), wid = __builtin_amdgcn_readfirstlane(tid >> 6), lane = tid & 63, r32 = lane & 31, hi = lane >> 5;
    const int sr = tid >> 4, sc = (tid & 15) * 8, kws = KSWZ(sr, sc * 2); char* K_lds = lds + 2 * SHM_V;
    const unsigned toffb = (unsigned)(sr * LDK + sc) * 2u, qoffb = (unsigned)(r32 * LDK + hi * 8) * 2u;
    const rsrc_t rP = mk_rsrc(B.PROJ, (unsigned)((size_t)::S * NP * 2));
    { const int qso = ((cur.P0 + wid * QBLK) * LDK + C_Q + cur.hd * 128) * 2;
#pragma unroll
      for (int d0 = 0; d0 < 8; ++d0) S.qr[d0] = bl_h8(rP, qoffb + d0 * 32, qso); }
    SLOAD_H(cur.hd, cur.t_lo * KVBLK); DMACK(cur.hd, cur.t_lo, 0); VMW(); SWRITE_HK(0);
    __syncthreads();
}
__device__ __forceinline__ void fox_block(const Bases& B, const BlockRef& cur, const BlockRef& nxt, char* lds, LAS unsigned char* lds3, Seam& S) {
    const int tid = otid(), wid = __builtin_amdgcn_readfirstlane(tid >> 6), lane = tid & 63, r32 = lane & 31, hi = lane >> 5;
    const int NT = cur.NT;
    const int qlo = cur.P0 + wid * QBLK, qm = qlo + r32 - 4 * hi;
    char* V_lds = lds; char* K_lds = lds + 2 * SHM_V;
    float* ws = (float*)(lds + 2 * SHM_V + 2 * SHM_K) + wid * 64; float* li_l = ws, * al_l = ws + 32;
    float m_reg = -1e30f, l_reg = 0; f32x16 o[4] = {};
    const int sr = tid >> 4, sc = (tid & 15) * 8, vst0 = v_st(sr, sc), vst1 = v_st(32 + sr, sc), kws = KSWZ(sr, sc * 2);
    const unsigned toffb = (unsigned)(sr * LDK + sc) * 2u, qoffb = (unsigned)(r32 * LDK + hi * 8) * 2u;
    const int vb0 = (int)(uintptr_t)V_lds + v_rd_base(lane);
    const rsrc_t rP = mk_rsrc(B.PROJ, (unsigned)((size_t)::S * NP * 2));
#define RESC(a) do { if (__any((a) < 1.f)) { if (hi == 0) al_l[r32] = (a); asm volatile("s_waitcnt lgkmcnt(0)" ::: "memory");              \
                     for (int d_ = 0; d_ < 4; ++d_) for (int r = 0; r < 16; ++r) o[d_][r] *= al_l[crow(r, hi)]; } } while (0)
#define KBASE(t) ((cur.t_lo + (t)) * KVBLK)
#define MASKT(P0_, P1_, t) do { const int kb_ = KBASE(t); if (kb_ + KVBLK - 1 > qlo) mask_tile(P0_, P1_, qm - kb_); } while (0)
    constexpr int NQL = 8;
#define SEAM_K0() do { VMWN(NQL); SWRITE_HK(0); SBAR(); } while (0)
    f32x16 pA0, pA1, pB0, pB1; float mnA, mnB, alA, alB; bf16x8 pa0, pa1, pa2, pa3;
    VMW(); SWRITE_HV(0); SBAR();
    const float cq = B.CS[(size_t)cur.hd * ::S + qlo + r32];
    const LAS float* cbp = (const LAS float*)(lds3 + CB_OFF) + 4 * hi;
    SLOAD_K(cur.hd, KBASE(1)); DMACK(cur.hd, cur.t_lo + 1, 1); SBAR(); SLOAD_V(cur.hd, KBASE(1));
    SBAR(); qkt<0>(pA0, pA1, K_lds, r32, hi, S.qr, cq, cbp);
    MASKT(pA0, pA1, 0); partialSM(pA0, pA1, m_reg, mnA, alA);
    VMWN(2); SWRITE_HK(1);
    __syncthreads();
#define HALF_STEP(PX0, PX1, mnX, alX, PY0, PY1, alY, t, KB, VB, SB) do {                                                      \
        SBAR(); if ((t) + 1 < NT) { SLOAD_K(cur.hd, KBASE((t) + 1)); DMACK(cur.hd, cur.t_lo + (t) + 1, SB); } SBAR();         \
        qkt<KB>(PX0, PX1, K_lds, r32, hi, S.qr, cq, cbp);                                                                     \
        finishSM(PY0, PY1, alY, l_reg, pa0, pa1, pa2, pa3); SBAR();                                                           \
        if ((t) + 1 < NT) { VMWN(2); } else { VMW(); }                                                                        \
        SWRITE_HV(KB); SBAR();                                                \
        if ((t) + 1 < NT) { SLOAD_V(cur.hd, KBASE((t) + 1)); SBAR(); }                                                        \
        pv_tile<VB>(o, vb0, pa0, pa1, pa2, pa3); SBAR();                                                                      \
        MASKT(PX0, PX1, (t)); partialSM(PX0, PX1, m_reg, mnX, alX);                                                           \
        __syncthreads();                                                                                                      \
        if ((t) + 1 < NT) { VMWN(2); SWRITE_HK(SB); }                         \
        RESC(alX); __syncthreads(); } while (0)
    for (int t = 1; t + 1 < NT; t += 2) {
        HALF_STEP(pB0, pB1, mnB, alB, pA0, pA1, alA, t, 1, 0, 0);
        HALF_STEP(pA0, pA1, mnA, alA, pB0, pB1, alB, t + 1, 0, 1, 1);
    }
    SBAR(); qkt<1>(pB0, pB1, K_lds, r32, hi, S.qr, cq, cbp); SBAR();
    VMW(); SWRITE_HV(1); SBAR();
    SLOAD_H(nxt.hd, nxt.t_lo * KVBLK); DMACK(nxt.hd, nxt.t_lo, 0); SBAR();
    { const int qso = ((nxt.P0 + wid * QBLK) * LDK + C_Q + nxt.hd * 128) * 2;
#pragma unroll
      for (int d0 = 0; d0 < 8; ++d0) S.qr[d0] = bl_h8(rP, qoffb + d0 * 32, qso); }
    SBAR();
    finishSM(pA0, pA1, alA, l_reg, pa0, pa1, pa2, pa3); SBAR();
    pv_tile<0>(o, vb0, pa0, pa1, pa2, pa3);
    MASKT(pB0, pB1, NT - 1); partialSM(pB0, pB1, m_reg, mnB, alB); __syncthreads(); RESC(alB);
    finishSM(pB0, pB1, alB, l_reg, pa0, pa1, pa2, pa3); SBAR(); pv_tile<1>(o, vb0, pa0, pa1, pa2, pa3);
    SBAR(); SEAM_K0();
    if (cur.direct) {
    if (hi == 0) li_l[r32] = l_reg; asm volatile("s_waitcnt lgkmcnt(0)" ::: "memory");
    float rli[16];
#pragma unroll
    for (int r = 0; r < 16; ++r) rli[r] = __builtin_amdgcn_rcpf(li_l[crow(r, hi)]);
    bf16_t* Ow = B.YCAT + (size_t)qlo * LDO + 1024 + cur.hd * 128; const int zso = (qlo * LDK + C_ZA + cur.hd * 128) * 2;
    const unsigned zoffb = (unsigned)(4 * hi * LDK + r32) * 2u, ooffb = (unsigned)(4 * hi * LDO + r32) * 2u;
#pragma unroll
    for (int rg = 0; rg < 16; rg += 8) {
        float zz[8][4];
#pragma unroll
        for (int r = rg; r < rg + 8; ++r) { const int orow = (r & 3) + 8 * (r >> 2);
#pragma unroll
            for (int d0 = 0; d0 < 4; ++d0) zz[r - rg][d0] = bf2f(bl_h1(rP, zoffb, zso + (orow * LDK + d0 * 32) * 2)); }
#pragma unroll
        for (int r = rg; r < rg + 8; ++r) { const int orow = (r & 3) + 8 * (r >> 2);
#pragma unroll
            for (int d0 = 0; d0 < 4; ++d0) { const float v = o[d0][r] * rli[r] * zz[r - rg][d0];
                const float vn = __shfl_xor(v, 1);
                if ((r32 & 1) == 0) *(unsigned*)((char*)(Ow + (size_t)orow * LDO + d0 * 32) + ooffb) = cvtpk(v, vn); } }
        SBAR(); }
    } else {
    asm volatile("s_nop 15\n\ts_nop 15" ::: "memory");
    unsigned* po = (unsigned*)B.PART + (size_t)cur.slot * PART_STRIDE + wid * 2048 + lane;
#pragma unroll
    for (int d0 = 0; d0 < 4; ++d0)
#pragma unroll
        for (int r = 0; r < 16; r += 2) po[(d0 * 8 + (r >> 1)) * 64] = cvtpk(o[d0][r], o[d0][r + 1]);
    float* pml = B.PART + (size_t)cur.slot * PART_STRIDE + 8 * 2048 + wid * 64;
    if (hi == 0) { pml[r32] = m_reg; pml[32 + r32] = l_reg; }
    }
    __syncthreads();
#undef RESC
#undef KBASE
#undef MASKT
#undef SEAM_K0
#undef HALF_STEP
}
#undef ROW
#undef VMW
#undef VMWN
#undef SLOAD_H
#undef SLOAD_K
#undef SLOAD_V
#undef SWRITE_HK
#undef SWRITE_HV
#undef SWRITE_H
#undef DMACK
#undef KSWZ
#undef SBAR
}


#ifndef ATT_SKIP
#define ATT_SKIP 1
#endif
constexpr int ATL_OFF = 69632;
constexpr int ATL_JLO = 0, ATL_PRE = 512, ATL_CNT = 512 + 2064, ATL_WT = 512 + 2 * 2064;
constexpr int SEG_OV = 4;
constexpr int NRM_WORD = 4096;
__device__ __forceinline__ int slot_lo(int jl, int k) { return jl > 64 * k ? jl : 64 * k; }
__device__ __forceinline__ int slot_len(int jl, int jh, int k) { const int a = slot_lo(jl, k), b = jh < 64 * (k + 1) ? jh : 64 * (k + 1); return b > a ? b - a : 0; }
__device__ __forceinline__ void att_build_list(LAS unsigned char* lds, const float* CS, const unsigned* nrm) {
    LAS int* L = (LAS int*)(lds + ATL_OFF); LAS int* jlo = L + ATL_JLO; LAS int* pre = L + ATL_PRE; LAS int* cnt = L + ATL_CNT; LAS int* wt = L + ATL_WT;
    const int tid = otid(), lane = tid & 63, wid = tid >> 6;
    {   const int e = tid, hd = e >> 6, qb = e & 63, jh = 4 * (qb + 1);
        int j_lo = 0;
#if ATT_SKIP
        const float q2 = __builtin_bit_cast(float, nrm[hd]), k2 = __builtin_bit_cast(float, nrm[8 + hd]);
        const float thr = 2.0f * sqrtf(q2 * k2) + 1300.0f;
        const float* c = CS + (size_t)hd * S; const float c0 = c[qb * 256];
        int lo = 0, hi = jh - 4;
        while (lo < hi) { const int mid = (lo + hi) >> 1; if (c[64 * mid + 63] - c0 <= thr) hi = mid; else lo = mid + 1; }
        j_lo = lo & ~1;
#endif
        jlo[e] = j_lo;
    }
    __syncthreads();
    {
        int len[4], nz[4]; int sl = 0, sn = 0;
#pragma unroll
        for (int i = 0; i < 4; ++i) { const int s = 4 * tid + i, qb = s & 63, k = (s >> 6) & 3, hd = s >> 8; len[i] = slot_len(jlo[hd * 64 + qb], 4 * (qb + 1), k); nz[i] = len[i] > 0 ? 1 : 0; len[i] += nz[i] * SEG_OV; sl += len[i]; sn += nz[i]; }
        int vl = sl, vn = sn;
#pragma unroll
        for (int o = 1; o < 64; o <<= 1) { const int a = __shfl_up(vl, o), b = __shfl_up(vn, o); if (lane >= o) { vl += a; vn += b; } }
        if (lane == 63) { wt[wid] = vl; wt[8 + wid] = vn; }
        __syncthreads();
        int ol = 0, on = 0;
        for (int w = 0; w < wid; ++w) { ol += wt[w]; on += wt[8 + w]; }
        int rl = vl - sl + ol, rn = vn - sn + on;
#pragma unroll
        for (int i = 0; i < 4; ++i) { pre[4 * tid + i] = rl; cnt[4 * tid + i] = rn; rl += len[i]; rn += nz[i]; }
        if (tid == NTHR - 1) { pre[2048] = rl; cnt[2048] = rn; }
    }
    __syncthreads();
}
__device__ __forceinline__ int att_find(const LAS int* pre, int g) { int lo = 0, hi = 2048; while (hi - lo > 1) { const int mid = (lo + hi) >> 1; if (pre[mid] <= g) lo = mid; else hi = mid; } return lo; }
__device__ __forceinline__ void att_combine(int e, int q, const float* PART, const bf16_t* PROJ, bf16_t* YCAT, LAS unsigned char* lds) {
    const LAS int* Lp = (const LAS int*)(lds + ATL_OFF); const LAS int* jlo = Lp + ATL_JLO; const LAS int* pre = Lp + ATL_PRE; const LAS int* cnt = Lp + ATL_CNT;
    LAS int* plist = (LAS int*)(lds + 4096);
    const int tid = otid(), lane = tid & 63, wid = __builtin_amdgcn_readfirstlane(tid >> 6), r32 = lane & 31, hi = lane >> 5;
    const int hd = e >> 6, qb = e & 63;
    if (tid == 0) { const int jl = jlo[e], jh = 4 * (qb + 1), k0 = jl >> 6, k1 = (jh - 1) >> 6; int n = 0;
        for (int k = k0; k <= k1; ++k) { const int s = (hd * 4 + k) * 64 + qb, c_ = cnt[s], ps = pre[s], ps1 = pre[s + 1], len = ps1 - ps - SEG_OV, va = ps / q, vb = (ps1 - 1) / q;
            for (int v = va; v <= vb && n < 64; ++v) { const int g0 = v * q, g1 = g0 + q; int x0 = (g0 > ps ? g0 : ps) - ps, x1 = (g1 < ps1 ? g1 : ps1) - ps; x0 = x0 < len ? x0 : len; x1 = x1 < len ? x1 : len;
                if (x1 > x0) plist[n++] = c_ + v; } }
        plist[64] = n; }
    __syncthreads();
    const int n = __builtin_amdgcn_readfirstlane(plist[64]);
    if (n > 1) {
        constexpr float C2 = 1.4426950408889634f * fox::SCALE;
        const int qlo = qb * 256 + wid * 32;
        LAS float* sc = (LAS float*)(lds) + wid * 64;
        float M = -3.0e38f, Lsum = 0.f;
        f32x16 acc[4] = {};
#define CMB_LOAD(W_, MC_, LC_, i_) do { const float* pb_ = PART + (size_t)__builtin_amdgcn_readfirstlane(plist[i_]) * PART_STRIDE;                   \
            MC_ = pb_[8 * 2048 + wid * 64 + r32]; LC_ = pb_[8 * 2048 + wid * 64 + 32 + r32]; const unsigned* po_ = (const unsigned*)pb_ + wid * 2048 + lane;   \
            _Pragma("unroll") for (int j_ = 0; j_ < 32; ++j_) W_[j_] = po_[j_ * 64]; } while (0)
#define CMB_PROC(W_, MC_, LC_) do { const float Mn = fmaxf(M, MC_), a = __builtin_amdgcn_exp2f((M - Mn) * C2), b = __builtin_amdgcn_exp2f((MC_ - Mn) * C2);       \
            Lsum = Lsum * a + LC_ * b; M = Mn;                                                                                                                 \
            if (hi == 0) { sc[r32] = a; sc[32 + r32] = b; }                                                                                                    \
            asm volatile("s_waitcnt lgkmcnt(0)" ::: "memory");                                                                                                 \
            float a_[16], b_[16];                                                                                                                              \
            _Pragma("unroll") for (int r = 0; r < 16; ++r) { a_[r] = sc[fox::crow(r, hi)]; b_[r] = sc[32 + fox::crow(r, hi)]; }                                 \
            asm volatile("s_waitcnt lgkmcnt(0)" ::: "memory");                                                                                                 \
            _Pragma("unroll") for (int d0 = 0; d0 < 4; ++d0) _Pragma("unroll") for (int r = 0; r < 16; r += 2) { const unsigned w2 = W_[d0 * 8 + (r >> 1)];     \
                acc[d0][r] = fmaf(bflo(w2), b_[r], acc[d0][r] * a_[r]); acc[d0][r + 1] = fmaf(bfhi(w2), b_[r + 1], acc[d0][r + 1] * a_[r + 1]); } } while (0)
        unsigned wA[32], wB[32]; float mcA, lcA, mcB = 0.f, lcB = 0.f;
        CMB_LOAD(wA, mcA, lcA, 0);
        for (int i = 0; i < n; i += 2) {
            if (i + 1 < n) CMB_LOAD(wB, mcB, lcB, i + 1);
            __builtin_amdgcn_sched_barrier(0);
            CMB_PROC(wA, mcA, lcA);
            if (i + 1 < n) {
                if (i + 2 < n) CMB_LOAD(wA, mcA, lcA, i + 2);
                __builtin_amdgcn_sched_barrier(0);
                CMB_PROC(wB, mcB, lcB);
            }
        }
#undef CMB_LOAD
#undef CMB_PROC
        if (hi == 0) sc[r32] = 1.0f / Lsum;
        asm volatile("s_waitcnt lgkmcnt(0)" ::: "memory");
        float rl_[16];
#pragma unroll
        for (int r = 0; r < 16; ++r) rl_[r] = sc[fox::crow(r, hi)];
        bf16_t* Ow = YCAT + (size_t)(qlo + 4 * hi) * DM + 1024 + hd * 128 + r32; const bf16_t* Zw = PROJ + (size_t)(qlo + 4 * hi) * NP + C_ZA + hd * 128 + r32;
#pragma unroll
        for (int rg = 0; rg < 16; rg += 8) {
            float zz[8][4];
#pragma unroll
            for (int r = rg; r < rg + 8; ++r) { const int orow = (r & 3) + 8 * (r >> 2);
#pragma unroll
                for (int d0 = 0; d0 < 4; ++d0) zz[r - rg][d0] = bf2f(Zw[(size_t)orow * NP + d0 * 32]); }
#pragma unroll
            for (int r = rg; r < rg + 8; ++r) { const int orow = (r & 3) + 8 * (r >> 2);
#pragma unroll
                for (int d0 = 0; d0 < 4; ++d0) { const float vv = acc[d0][r] * rl_[r] * zz[r - rg][d0];
                    const float vn = __shfl_xor(vv, 1);
                    if ((r32 & 1) == 0) *(unsigned*)(Ow + (size_t)orow * DM + d0 * 32) = fox::cvtpk(vv, vn); } }
            __builtin_amdgcn_sched_barrier(0); }
    }
    __syncthreads();
}
__device__ __forceinline__ void att_norms(const bf16_t* PROJ, unsigned* nrm, LAS unsigned char* lds, int gw, int NGW, int lane) {
    float mq0 = 0.f, mq1 = 0.f, mk0 = 0.f, mk1 = 0.f;
#define SS8(v) ((bflo(v.x) * bflo(v.x) + bfhi(v.x) * bfhi(v.x)) + (bflo(v.y) * bflo(v.y) + bfhi(v.y) * bfhi(v.y)) + (bflo(v.z) * bflo(v.z) + bfhi(v.z) * bfhi(v.z)) + (bflo(v.w) * bflo(v.w) + bfhi(v.w) * bfhi(v.w)))
    for (int row0 = gw; row0 < S; row0 += 4 * NGW) {
        u32x4 a[4], b[4], c[4], d[4];
#pragma unroll
        for (int u = 0; u < 4; ++u) { const int row = row0 + u * NGW; const bf16_t* rp = PROJ + (size_t)(row < S ? row : 0) * NP + lane * 8;
            a[u] = *(const u32x4*)(rp + C_Q); b[u] = *(const u32x4*)(rp + C_Q + 512); c[u] = *(const u32x4*)(rp + C_K); d[u] = *(const u32x4*)(rp + C_K + 512); }
#pragma unroll
        for (int u = 0; u < 4; ++u) {
            float sa = SS8(a[u]), sb = SS8(b[u]), sc_ = SS8(c[u]), sd = SS8(d[u]);
            sa += __builtin_bit_cast(float, __builtin_amdgcn_update_dpp(0, __builtin_bit_cast(int, sa), 0xB1, 0xF, 0xF, true)); sb += __builtin_bit_cast(float, __builtin_amdgcn_update_dpp(0, __builtin_bit_cast(int, sb), 0xB1, 0xF, 0xF, true));
            sc_ += __builtin_bit_cast(float, __builtin_amdgcn_update_dpp(0, __builtin_bit_cast(int, sc_), 0xB1, 0xF, 0xF, true)); sd += __builtin_bit_cast(float, __builtin_amdgcn_update_dpp(0, __builtin_bit_cast(int, sd), 0xB1, 0xF, 0xF, true));
            sa += __builtin_bit_cast(float, __builtin_amdgcn_update_dpp(0, __builtin_bit_cast(int, sa), 0x4E, 0xF, 0xF, true)); sb += __builtin_bit_cast(float, __builtin_amdgcn_update_dpp(0, __builtin_bit_cast(int, sb), 0x4E, 0xF, 0xF, true));
            sc_ += __builtin_bit_cast(float, __builtin_amdgcn_update_dpp(0, __builtin_bit_cast(int, sc_), 0x4E, 0xF, 0xF, true)); sd += __builtin_bit_cast(float, __builtin_amdgcn_update_dpp(0, __builtin_bit_cast(int, sd), 0x4E, 0xF, 0xF, true));
            sa += __builtin_bit_cast(float, __builtin_amdgcn_update_dpp(0, __builtin_bit_cast(int, sa), 0x141, 0xF, 0xF, true)); sb += __builtin_bit_cast(float, __builtin_amdgcn_update_dpp(0, __builtin_bit_cast(int, sb), 0x141, 0xF, 0xF, true));
            sc_ += __builtin_bit_cast(float, __builtin_amdgcn_update_dpp(0, __builtin_bit_cast(int, sc_), 0x141, 0xF, 0xF, true)); sd += __builtin_bit_cast(float, __builtin_amdgcn_update_dpp(0, __builtin_bit_cast(int, sd), 0x141, 0xF, 0xF, true));
            sa += __builtin_bit_cast(float, __builtin_amdgcn_update_dpp(0, __builtin_bit_cast(int, sa), 0x140, 0xF, 0xF, true)); sb += __builtin_bit_cast(float, __builtin_amdgcn_update_dpp(0, __builtin_bit_cast(int, sb), 0x140, 0xF, 0xF, true));
            sc_ += __builtin_bit_cast(float, __builtin_amdgcn_update_dpp(0, __builtin_bit_cast(int, sc_), 0x140, 0xF, 0xF, true)); sd += __builtin_bit_cast(float, __builtin_amdgcn_update_dpp(0, __builtin_bit_cast(int, sd), 0x140, 0xF, 0xF, true));
            if (row0 + u * NGW < S) { mq0 = fmaxf(mq0, sa); mq1 = fmaxf(mq1, sb); mk0 = fmaxf(mk0, sc_); mk1 = fmaxf(mk1, sd); } }
    }
#undef SS8
    const int wid = otid() >> 6;
    LAS float* red = (LAS float*)lds;
    if ((lane & 15) == 0) { const int hq = lane >> 4; red[wid * 16 + hq] = mq0; red[wid * 16 + 4 + hq] = mq1; red[wid * 16 + 8 + hq] = mk0; red[wid * 16 + 12 + hq] = mk1; }
    __syncthreads();
    if (wid == 0 && lane < 16) { float m = red[lane];
#pragma unroll
        for (int w = 1; w < 8; ++w) m = fmaxf(m, red[w * 16 + lane]);
        atomicMax(nrm + lane, __builtin_bit_cast(unsigned, m)); }
    __syncthreads();
}


#define XB_TMO      128
#define XB_XCNT(j)  (256  + 64 * (j))
#define XB_XSUB(j)  (1280 + 64 * (j))
#define XB_XGEN(j)  (2304 + 64 * (j))
#define XB_TOP      3328
#define XB_TOPGEN   3392
#define XCD_BAR_WORDS 3456
#define XB_SPIN_CAP (1u << 20)
__device__ __forceinline__ unsigned xb_ld(unsigned* p)              { return __hip_atomic_load(p, __ATOMIC_RELAXED, __HIP_MEMORY_SCOPE_AGENT); }
__device__ __forceinline__ unsigned xb_add(unsigned* p, unsigned v) { return __hip_atomic_fetch_add(p, v, __ATOMIC_RELAXED, __HIP_MEMORY_SCOPE_AGENT); }
__device__ __forceinline__ unsigned xb_xcc_id() { return (unsigned)__builtin_amdgcn_s_getreg((3 << 11) | 20) & 0xFu; }
#define XB_SPIN(cond, bar) do { unsigned _sp = 0; while (cond) { __builtin_amdgcn_s_sleep(1); \
    if ((++_sp & 255u) == 0u) { if (xb_ld(&(bar)[XB_TMO])) break; if (_sp > XB_SPIN_CAP) { atomicAdd(&(bar)[XB_TMO], 1u); break; } } } } while (0)
struct XcdBarrier { unsigned* bar; unsigned x; volatile LAS unsigned* st; };
__device__ __forceinline__ XcdBarrier xcd_barrier_post(unsigned* bar, volatile LAS unsigned* st) {
    XcdBarrier b; b.bar = bar; b.x = xb_xcc_id(); b.st = st;
    if (threadIdx.x == 0) (void)xb_add(&bar[XB_XCNT(b.x)], 1u);
    return b;
}
__device__ __forceinline__ void xcd_barrier_complete(unsigned* bar, unsigned x, unsigned& nloc, unsigned& nx) {
    const unsigned G = gridDim.x * gridDim.y * gridDim.z;
    unsigned sum, cnt, mine, sp = 0u;
    for (;;) {
        sum = 0u; cnt = 0u; mine = 0u;
#pragma unroll
        for (unsigned j = 0; j < 16; ++j) { const unsigned c = xb_ld(&bar[XB_XCNT(j)]); sum += c; cnt += (c > 0u) ? 1u : 0u; mine = (j == x) ? c : mine; }
        if (sum == G) break;
        __builtin_amdgcn_s_sleep(1);
        if ((++sp & 255u) == 0u) { if (xb_ld(&bar[XB_TMO])) break; if (sp > XB_SPIN_CAP) { atomicAdd(&bar[XB_TMO], 1u); break; } }
    }
    nloc = mine > 0u ? mine : 1u; nx = cnt > 0u ? cnt : 1u;
}
__device__ __forceinline__ void xcd_barrier(const XcdBarrier& b) {
    asm volatile("s_waitcnt vmcnt(0)" ::: "memory");
    __syncthreads();
    if (threadIdx.x == 0) {
        unsigned* bar = b.bar;
        __builtin_amdgcn_s_waitcnt(0);
        unsigned nloc = b.st[0], nx = b.st[1];
        if (nloc == 0u) { xcd_barrier_complete(bar, b.x, nloc, nx); b.st[0] = nloc; b.st[1] = nx; }
        const unsigned old = xb_add(&bar[XB_XSUB(b.x)], 1u);
        const unsigned gen = old / nloc;
        if (old + 1u == (gen + 1u) * nloc) {
            __builtin_amdgcn_fence(__ATOMIC_RELEASE, "agent");
            asm volatile("s_waitcnt vmcnt(0)" ::: "memory");
            const unsigned og = xb_add(&bar[XB_TOP], 1u);
            const unsigned tg = og / nx;
            if (og + 1u == (tg + 1u) * nx) xb_add(&bar[XB_TOPGEN], 1u);
            else XB_SPIN(xb_ld(&bar[XB_TOPGEN]) == tg, bar);
            __builtin_amdgcn_fence(__ATOMIC_ACQUIRE, "agent");
            xb_add(&bar[XB_XGEN(b.x)], 1u);
            asm volatile("s_waitcnt vmcnt(0)" ::: "memory");
        } else {
            XB_SPIN(xb_ld(&bar[XB_XGEN(b.x)]) == gen, bar);
            __builtin_amdgcn_fence(__ATOMIC_ACQUIRE, "agent");
            asm volatile("s_waitcnt vmcnt(0)" ::: "memory");
        }
    }
    __syncthreads();
}

struct KArgs { const float* in[19]; float* out; unsigned char* ws; int ph_lo, ph_hi; };
enum { I_X = 0, I_P, I_NPRE, I_WIN, I_BF, I_DW, I_DWB, I_CLG, I_CLB, I_PW, I_PWB, I_SLG, I_SLB, I_SW, I_SB, I_WOUT, I_NPOST, I_WPG, I_WPP };

__device__ __forceinline__ void transpose_item(const float* W, int ldw, int K, bf16_t* WT, LAS float* scr, int kb, int n0_dst, int n0_src, int lane) {
    const int k0 = 64 * kb;
    float tv[32];
#pragma unroll
    for (int i = 0; i < 32; ++i) { const int kk = 2 * i + (lane >> 5); tv[i] = __builtin_nontemporal_load(W + (size_t)(k0 + kk) * ldw + n0_src + (lane & 31)); }
#pragma unroll
    for (int i = 0; i < 32; ++i) { const int kk = 2 * i + (lane >> 5); scr[kk * 33 + (lane & 31)] = tv[i]; }
    asm volatile("s_waitcnt lgkmcnt(0)" ::: "memory");
    const int c = lane & 7;
#pragma unroll
    for (int j = 0; j < 4; ++j) { const int n = (lane >> 3) + 8 * j; const LAS float* s = scr + (8 * c) * 33 + n;
        u32x4 o; o.x = pk2(s[0 * 33], s[1 * 33]); o.y = pk2(s[2 * 33], s[3 * 33]); o.z = pk2(s[4 * 33], s[5 * 33]); o.w = pk2(s[6 * 33], s[7 * 33]);
        *(u32x4*)(WT + (size_t)(n0_dst + n) * K + k0 + 8 * c) = o; }
    asm volatile("s_waitcnt lgkmcnt(0)" ::: "memory");
}

__device__ __forceinline__ void prep_phase(const KArgs& a, LAS unsigned char* lds, int gw, int NGW, int wave, int lane) {
    LAS float* scr = (LAS float*)(lds + wave * 16384);
    unsigned char* ws = a.ws;
    constexpr int I_IN = 32 * 224, I_SQ = 32 * 64, I_PP = 4 * 64, I_PWI = 8 * 16, I_L = I_IN + 2 * I_SQ + I_PP + I_PWI;
    for (int it = gw; it < DEPTH * I_L; it += NGW) {
        const int l = it / I_L; int r = it - l * I_L;
        if (r < I_IN) { const int kb = r / 224, nb = r % 224, n0 = 32 * nb; transpose_item(a.in[I_WIN] + (size_t)l * DM * NIN, NIN, DM, (bf16_t*)(ws + WS_WIN + l * SZ_WIN), scr, kb, n0, n0 + (n0 >= 4096 ? 8 : 0), lane); continue; } r -= I_IN;
        if (r < I_SQ) { const int kb = r / 64, nb = r % 64; transpose_item(a.in[I_WOUT] + (size_t)l * DM * DM, DM, DM, (bf16_t*)(ws + WS_WOUT + l * SZ_WSQ), scr, kb, 32 * nb, 32 * nb, lane); continue; } r -= I_SQ;
        if (r < I_SQ) { const int kb = r / 64, nb = r % 64; transpose_item(a.in[I_WPG] + (size_t)l * DM * DM, DM, DM, (bf16_t*)(ws + WS_WPG + l * SZ_WSQ), scr, kb, 32 * nb, 32 * nb, lane); continue; } r -= I_SQ;
        if (r < I_PP) { const int kb = r / 64, nb = r % 64; transpose_item(a.in[I_WPP] + (size_t)l * PLE * DM, DM, PLE, (bf16_t*)(ws + WS_WPP + l * SZ_WPP), scr, kb, 32 * nb, 32 * nb, lane); continue; } r -= I_PP;
        { const int kb = r / 16, nb = r % 16; transpose_item(a.in[I_PW] + (size_t)l * 512 * 512, 512, 512, (bf16_t*)(ws + WS_WPW + l * SZ_WPW), scr, kb, 32 * nb, 32 * nb, lane); }
    }
    const int gt = gw * 64 + lane, NGT = NGW * 64;
    { const float* sw = a.in[I_SW]; bf16_t* o = (bf16_t*)(ws + WS_SW);
      for (int i = gt; i < DEPTH * 4 * 128 * 128; i += NGT) { const int s_ = i & 127, t_ = (i >> 7) & 127; o[i] = (bf16_t)(s_ <= t_ ? f2bf(sw[i]) : 0u); } }
    { const f32x4* p4 = (const f32x4*)a.in[I_P]; u32x2* o = (u32x2*)(ws + WS_PB);
      constexpr int NP4 = DEPTH * S * PLE / 4;
      for (int i0 = gt; i0 < NP4; i0 += 8 * NGT) { f32x4 v[8];
#pragma unroll
          for (int u = 0; u < 8; ++u) { const int i = i0 + u * NGT; v[u] = i < NP4 ? __builtin_nontemporal_load(p4 + i) : (f32x4){0.f, 0.f, 0.f, 0.f}; }
#pragma unroll
          for (int u = 0; u < 8; ++u) { const int i = i0 + u * NGT; if (i < NP4) { u32x2 w; w.x = pk2(v[u][0], v[u][1]); w.y = pk2(v[u][2], v[u][3]); o[i] = w; } } } }
}

__device__ __forceinline__ void rows_pre(const float* h, const float* g, const float* w_in_l, const float* bf_l, bf16_t* XN, float* FL, LAS unsigned char* lds, int gw, int NGW, int lane) {
    LAS float* tab = (LAS float*)lds;
    {   const int t_ = otid(); float tv[32];
#pragma unroll
        for (int u = 0; u < 32; ++u) { const int i = t_ + u * NTHR; tv[u] = w_in_l[(size_t)(i >> 3) * NIN + 4096 + (i & 7)]; }
#pragma unroll
        for (int u = 0; u < 32; ++u) { const int i = t_ + u * NTHR; tab[(i & 7) * DM + (i >> 3)] = tv[u]; } }
    __syncthreads();
    for (int row0 = gw; row0 < S; row0 += 2 * NGW) {
        f32x4 v[2][8];
#pragma unroll
        for (int u = 0; u < 2; ++u) { const int row = row0 + u * NGW; const f32x4* xr = (const f32x4*)(h + (size_t)row * DM) + lane;
#pragma unroll
            for (int j = 0; j < 8; ++j) v[u][j] = __builtin_nontemporal_load(xr + 64 * j); }
#pragma unroll
        for (int u = 0; u < 2; ++u) { const int row = row0 + u * NGW;
            float ss = 0.f;
#pragma unroll
            for (int j = 0; j < 8; ++j) ss += (v[u][j][0] * v[u][j][0] + v[u][j][1] * v[u][j][1]) + (v[u][j][2] * v[u][j][2] + v[u][j][3] * v[u][j][3]);
            ss = wave_sum(ss);
            const float inv = 1.0f / sqrtf(ss * (1.0f / DM) + EPS);
            float acc[8];
#pragma unroll
            for (int e = 0; e < 8; ++e) acc[e] = 0.f;
            u32x2* o8 = (u32x2*)(XN + (size_t)row * DM) + lane;
#pragma unroll
            for (int j = 0; j < 8; ++j) { const f32x4 gg = *((const f32x4*)g + 64 * j + lane); const f32x4 xg = v[u][j] * gg;
                u32x2 w; w.x = pk2(xg[0] * inv, xg[1] * inv); w.y = pk2(xg[2] * inv, xg[3] * inv); o8[64 * j] = w;
#pragma unroll
                for (int e = 0; e < 8; ++e) { const f32x4 wv = *(const LAS f32x4*)(tab + e * DM + j * 256 + lane * 4); acc[e] += (xg[0] * wv[0] + xg[1] * wv[1]) + (xg[2] * wv[2] + xg[3] * wv[3]); }
                __builtin_amdgcn_sched_barrier(0); }
#pragma unroll
            for (int e = 0; e < 8; ++e) acc[e] = wave_sum(acc[e]);
            float mine = acc[0];
#pragma unroll
            for (int e = 1; e < 8; ++e) mine = (lane == e) ? acc[e] : mine;
            if (lane < 8) { const float f = mine * inv + bf_l[lane]; const float ls = fminf(f, 0.f) - log1pf(expf(-fabsf(f))); FL[(size_t)row * 8 + lane] = ls; }
        }
    }
    __syncthreads();
}

__device__ __forceinline__ void scan_head(const float* FL, float* CS, int hd, LAS unsigned char* lds) {
    LAS double* part = (LAS double*)lds;
    const int tid = otid();
    float v[32]; double s = 0.0;
#pragma unroll
    for (int i = 0; i < 32; ++i) { v[i] = FL[(size_t)(tid * 32 + i) * 8 + hd]; s += (double)v[i]; }
    double vs = s;
#pragma unroll
    for (int o = 1; o < 64; o <<= 1) { const double n = __shfl_up(vs, o); if ((tid & 63) >= o) vs += n; }
    if ((tid & 63) == 63) part[tid >> 6] = vs;
    __syncthreads();
    double run = vs - s;
    for (int w = 0; w < (tid >> 6); ++w) run += part[w];
#pragma unroll
    for (int i = 0; i < 32; ++i) { run += (double)v[i]; CS[(size_t)hd * S + tid * 32 + i] = (float)(run * 11.313708498984761); }
    __syncthreads();
}

__device__ __forceinline__ void conv_item(int item, const bf16_t* PROJ, const float* dw, const float* dwb, const float* lng, const float* lnb,
                                          const bf16_t* Wpw, const float* pwb, bf16_t* YCAT, LAS unsigned char* lds) {
    const int tid = otid(), wid = __builtin_amdgcn_readfirstlane(tid >> 6), lane = tid & 63, r32 = lane & 31, hi = lane >> 5;
    const int t0 = item * 32, c = tid;
    LAS float* cbuf = (LAS float*)lds;
    LAS bf16_t* abuf = (LAS bf16_t*)(lds + 65536);
    {
        float w[31];
#pragma unroll
        for (int j = 0; j < 31; ++j) w[j] = dw[j * 512 + c];
        float y[62];
        bf16_t ra[62], rb[62];
#pragma unroll
        for (int i = 0; i < 62; ++i) { const int t = t0 - 30 + i, tt = t < 0 ? 0 : t; ra[i] = PROJ[(size_t)tt * NP + C_GA + c]; rb[i] = PROJ[(size_t)tt * NP + C_GB + c]; }
#pragma unroll
        for (int i = 0; i < 62; ++i) { const int t = t0 - 30 + i; const float yv = bf2f(ra[i]) * bf2f(rb[i]); y[i] = t >= 0 ? yv : 0.f; }
        const float bias = dwb[c];
#pragma unroll
        for (int t = 0; t < 32; ++t) { float acc = bias;
#pragma unroll
            for (int j = 0; j < 31; ++j) acc = fmaf(w[j], y[t + j], acc);
            cbuf[t * 512 + c] = acc; }
    }
    __syncthreads();
    {
        const f32x4 g0 = *(const f32x4*)(lng + lane * 8), g1 = *(const f32x4*)(lng + lane * 8 + 4), b0 = *(const f32x4*)(lnb + lane * 8), b1 = *(const f32x4*)(lnb + lane * 8 + 4);
#pragma unroll
        for (int rr = 0; rr < 4; ++rr) { const int row = wid * 4 + rr;
            const f32x4 v0 = *(const LAS f32x4*)(cbuf + row * 512 + lane * 8), v1 = *(const LAS f32x4*)(cbuf + row * 512 + lane * 8 + 4);
            const float mean = wave_sum((v0[0] + v0[1]) + (v0[2] + v0[3]) + (v1[0] + v1[1]) + (v1[2] + v1[3])) * (1.f / 512.f);
            const f32x4 d0 = v0 - mean, d1 = v1 - mean;
            const float var = wave_sum((d0[0] * d0[0] + d0[1] * d0[1]) + (d0[2] * d0[2] + d0[3] * d0[3]) + (d1[0] * d1[0] + d1[1] * d1[1]) + (d1[2] * d1[2] + d1[3] * d1[3])) * (1.f / 512.f);
            const float rstd = 1.0f / sqrtf(var + EPS);
            const f32x4 y0 = d0 * rstd * g0 + b0, y1 = d1 * rstd * g1 + b1;
            u32x4 w; w.x = pk2(silu_f(y0[0]), silu_f(y0[1])); w.y = pk2(silu_f(y0[2]), silu_f(y0[3])); w.z = pk2(silu_f(y1[0]), silu_f(y1[1])); w.w = pk2(silu_f(y1[2]), silu_f(y1[3]));
            *(LAS u32x4*)(abuf + row * 520 + lane * 8) = w; }
    }
    __syncthreads();
    {
        f32x16 acc0 = {}, acc1 = {};
        const bf16_t* w0p = Wpw + (size_t)(wid * 64 + r32) * 512 + hi * 8; const bf16_t* w1p = w0p + 32 * 512;
        const LAS bf16_t* ap = abuf + r32 * 520 + hi * 8;
        bf16x8 Ba0[8], Ba1[8], Bb0[8], Bb1[8];
#define LDG(B0_, B1_, g_) do { _Pragma("unroll") for (int k_ = 0; k_ < 8; ++k_) { B0_[k_] = *(const bf16x8*)(w0p + ((g_) * 8 + k_) * 16); B1_[k_] = *(const bf16x8*)(w1p + ((g_) * 8 + k_) * 16); } } while (0)
#define MMG(B0_, B1_, g_) do { _Pragma("unroll") for (int k_ = 0; k_ < 8; ++k_) { const bf16x8 af = *(const LAS bf16x8*)(ap + ((g_) * 8 + k_) * 16); \
            acc0 = __builtin_amdgcn_mfma_f32_32x32x16_bf16(af, B0_[k_], acc0, 0, 0, 0); acc1 = __builtin_amdgcn_mfma_f32_32x32x16_bf16(af, B1_[k_], acc1, 0, 0, 0); } } while (0)
        LDG(Ba0, Ba1, 0); __builtin_amdgcn_sched_barrier(0);
        LDG(Bb0, Bb1, 1); __builtin_amdgcn_sched_barrier(0);
        MMG(Ba0, Ba1, 0); __builtin_amdgcn_sched_barrier(0);
        LDG(Ba0, Ba1, 2); __builtin_amdgcn_sched_barrier(0);
        MMG(Bb0, Bb1, 1); __builtin_amdgcn_sched_barrier(0);
        LDG(Bb0, Bb1, 3); __builtin_amdgcn_sched_barrier(0);
        MMG(Ba0, Ba1, 2); __builtin_amdgcn_sched_barrier(0);
        MMG(Bb0, Bb1, 3);
#undef LDG
#undef MMG
        const int n0 = wid * 64 + r32, n1 = n0 + 32; const float pb0 = pwb[n0], pb1 = pwb[n1];
        bf16_t zr0[16], zr1[16];
#pragma unroll
        for (int r = 0; r < 16; ++r) { const int t = t0 + fox::crow(r, hi); zr0[r] = PROJ[(size_t)t * NP + C_ZC + n0]; zr1[r] = PROJ[(size_t)t * NP + C_ZC + n1]; }
#pragma unroll
        for (int r = 0; r < 16; ++r) { const int t = t0 + fox::crow(r, hi);
            YCAT[(size_t)t * DM + n0] = (bf16_t)f2bf((acc0[r] + pb0) * bf2f(zr0[r])); YCAT[(size_t)t * DM + n1] = (bf16_t)f2bf((acc1[r] + pb1) * bf2f(zr1[r])); }
    }
    __syncthreads();
}

__device__ __forceinline__ void sgu_item(int item, const bf16_t* PROJ, const float* lng, const float* lnb, const bf16_t* Wm  , const float* bs  ,
                                         bf16_t* YCAT, LAS unsigned char* lds) {
    const int tid = otid(), wid = __builtin_amdgcn_readfirstlane(tid >> 6), lane = tid & 63, r32 = lane & 31, hi = lane >> 5;
    const int chunk = item >> 2, h = item & 3, t0 = chunk * 128;
    LAS bf16_t* vT = (LAS bf16_t*)lds;
    const int tb = wid & 3, db = (wid >> 2) * 2;
    const int c0 = h * 128 + db * 32 + r32, c1 = c0 + 32;
    bf16x8 wfs[8];
    {   const bf16_t* wp = Wm + (size_t)(h * 128 + tb * 32 + r32) * 128 + hi * 8;
#pragma unroll
        for (int ks = 0; ks < 8; ++ks) wfs[ks] = *(const bf16x8*)(wp + ks * 16); }
    bf16_t ur0[16], ur1[16], zr0[16], zr1[16]; float bbr[16];
#pragma unroll
    for (int r = 0; r < 16; ++r) { const int tl = tb * 32 + fox::crow(r, hi); const size_t rowoff = (size_t)(t0 + tl) * NP; bbr[r] = bs[h * 128 + tl];
        ur0[r] = PROJ[rowoff + C_U + c0]; ur1[r] = PROJ[rowoff + C_U + c1]; zr0[r] = PROJ[rowoff + C_ZS + c0]; zr1[r] = PROJ[rowoff + C_ZS + c1]; }
    {
        const f32x4 g0 = *(const f32x4*)(lng + lane * 8), g1 = *(const f32x4*)(lng + lane * 8 + 4), b0 = *(const f32x4*)(lnb + lane * 8), b1 = *(const f32x4*)(lnb + lane * 8 + 4);
        u32x4 raws[16];
#pragma unroll
        for (int rr = 0; rr < 16; ++rr) raws[rr] = *(const u32x4*)(PROJ + (size_t)(t0 + wid * 16 + rr) * NP + C_VS + lane * 8);
#pragma unroll
        for (int rr = 0; rr < 16; ++rr) { const int s_ = wid * 16 + rr;
            const u32x4 raw = raws[rr];
            float gv[8]; gv[0] = bflo(raw.x); gv[1] = bfhi(raw.x); gv[2] = bflo(raw.y); gv[3] = bfhi(raw.y);
            gv[4] = bflo(raw.z); gv[5] = bfhi(raw.z); gv[6] = bflo(raw.w); gv[7] = bfhi(raw.w);
            const float mean = wave_sum((gv[0] + gv[1]) + (gv[2] + gv[3]) + (gv[4] + gv[5]) + (gv[6] + gv[7])) * (1.f / 512.f);
            float q = 0.f;
#pragma unroll
            for (int i = 0; i < 8; ++i) { gv[i] -= mean; q += gv[i] * gv[i]; }
            const float rstd = 1.0f / sqrtf(wave_sum(q) * (1.f / 512.f) + EPS);
            if ((lane >> 4) == h) { const int d = (lane & 15) * 8;
#pragma unroll
                for (int i = 0; i < 4; ++i) { vT[(d + i) * 136 + s_] = (bf16_t)f2bf(gv[i] * rstd * g0[i] + b0[i]); vT[(d + 4 + i) * 136 + s_] = (bf16_t)f2bf(gv[4 + i] * rstd * g1[i] + b1[i]); } }
        }
    }
    __syncthreads();
    {
        f32x16 acc0 = {}, acc1 = {};
        const LAS bf16_t* v0p = vT + (db * 32 + r32) * 136 + hi * 8; const LAS bf16_t* v1p = v0p + 32 * 136;
#pragma unroll
        for (int ks = 0; ks < 8; ++ks) { if (ks < 2 * (tb + 1)) { const bf16x8 x0 = *(const LAS bf16x8*)(v0p + ks * 16), x1 = *(const LAS bf16x8*)(v1p + ks * 16);
            acc0 = __builtin_amdgcn_mfma_f32_32x32x16_bf16(wfs[ks], x0, acc0, 0, 0, 0); acc1 = __builtin_amdgcn_mfma_f32_32x32x16_bf16(wfs[ks], x1, acc1, 0, 0, 0); } }
#pragma unroll
        for (int r = 0; r < 16; ++r) { const int tl = tb * 32 + fox::crow(r, hi);
            const float u0 = bf2f(ur0[r]), u1 = bf2f(ur1[r]), z0 = bf2f(zr0[r]), z1 = bf2f(zr1[r]);
            YCAT[(size_t)(t0 + tl) * DM + 512 + c0] = (bf16_t)f2bf(u0 * (acc0[r] + bbr[r]) * z0); YCAT[(size_t)(t0 + tl) * DM + 512 + c1] = (bf16_t)f2bf(u1 * (acc1[r] + bbr[r]) * z1); }
    }
    __syncthreads();
}

__device__ __forceinline__ void rows_post(const float* hsrc, const bf16_t* Y, const float* g, float* H, bf16_t* XN, int gw, int NGW, int lane) {
    for (int row0 = gw; row0 < S; row0 += 2 * NGW) {
        f32x4 v[2][8], hv[2][8];
#pragma unroll
        for (int u = 0; u < 2; ++u) { const int row = row0 + u * NGW; const u32x2* yr = (const u32x2*)(Y + (size_t)row * DM) + lane; const f32x4* hr = (const f32x4*)(hsrc + (size_t)row * DM) + lane;
#pragma unroll
            for (int j = 0; j < 8; ++j) { const u32x2 yw = __builtin_nontemporal_load(yr + 64 * j); v[u][j] = (f32x4){bflo(yw.x), bfhi(yw.x), bflo(yw.y), bfhi(yw.y)}; hv[u][j] = __builtin_nontemporal_load(hr + 64 * j); } }
#pragma unroll
        for (int u = 0; u < 2; ++u) { const int row = row0 + u * NGW;
            float ss = 0.f;
#pragma unroll
            for (int j = 0; j < 8; ++j) ss += (v[u][j][0] * v[u][j][0] + v[u][j][1] * v[u][j][1]) + (v[u][j][2] * v[u][j][2] + v[u][j][3] * v[u][j][3]);
            ss = wave_sum(ss);
            const float inv = 1.0f / sqrtf(ss * (1.0f / DM) + EPS);
            f32x4* ho = (f32x4*)(H + (size_t)row * DM) + lane; u32x2* o8 = (u32x2*)(XN + (size_t)row * DM) + lane;
#pragma unroll
            for (int j = 0; j < 8; ++j) { const f32x4 gg = *((const f32x4*)g + 64 * j + lane); const f32x4 r = hv[u][j] + v[u][j] * inv * gg;
                ho[64 * j] = r; u32x2 w; w.x = pk2(r[0], r[1]); w.y = pk2(r[2], r[3]); o8[64 * j] = w; }
        }
    }
}

template <bool COOP>
__global__ void __launch_bounds__(NTHR, 2) fwd_kernel(KArgs a) {
    extern __shared__ __attribute__((aligned(16))) unsigned char lds_raw[];
    LAS unsigned char* lds = (LAS unsigned char*)lds_raw;
    const int G = gridDim.x, bx = blockIdx.x;
    const int vcu = (G % 8 == 0) ? (bx % 8) * (G / 8) + bx / 8 : bx;
    const int NGW = G * NWAVES;
#define PH_IDS const int tid_ = otid(), lane = tid_ & 63, wave = __builtin_amdgcn_readfirstlane(tid_ >> 6), gw = vcu * NWAVES + wave
    unsigned char* ws = a.ws;
    bf16_t* XN = (bf16_t*)(ws + WS_XN); bf16_t* YCAT = (bf16_t*)(ws + WS_YCAT); bf16_t* PROJ = (bf16_t*)(ws + WS_PROJ);
    bf16_t* Y = (bf16_t*)(ws + WS_Y); bf16_t* PBUF = (bf16_t*)(ws + WS_PBUF); float* FL = (float*)(ws + WS_FL); float* CS = (float*)(ws + WS_CS);
    float* H = a.out;
    const int lo = a.ph_lo, hi_ = a.ph_hi;
#ifndef PHMASK
#define PHMASK 0xFFF
#endif
#define IN(k) (lo <= (k) && (k) < hi_)
    XcdBarrier xbar; xbar.bar = nullptr; xbar.x = 0; xbar.st = nullptr;
    if (COOP) {
        if (threadIdx.x < 2) ((volatile LAS unsigned*)(lds + MISC_OFF))[threadIdx.x] = 0u;
        __syncthreads();
        xbar = xcd_barrier_post((unsigned*)(ws + WS_CTL), (volatile LAS unsigned*)(lds + MISC_OFF));
    }
    if (COOP && a.ph_lo < 0) cg::this_grid().sync();
#define SEAM(k) do { if (COOP) { if (IN(k) && IN((k) + 1)) xcd_barrier(xbar); } } while (0)

    if (IN(0)) {
        for (int rep_ = 0; rep_ < DUP_PREP; ++rep_) { PH_IDS; prep_phase(a, lds, gw, NGW, wave, lane); }
        __syncthreads();
        PH_IDS; rows_pre(a.in[I_X], a.in[I_NPRE], a.in[I_WIN], a.in[I_BF], XN, FL, lds, gw, NGW, lane);
    }
    SEAM(0);
#pragma unroll 1
    for (int l = 0; l < DEPTH; ++l) {
        const int pb = 1 + 8 * l;
        const float* hsrc = (l == 0) ? a.in[I_X] : H;
        if (IN(pb)) {
            if (bx < 8) scan_head(FL, CS, bx, lds);
            pg8::Gemm g{XN, (const bf16_t*)(ws + WS_WIN + l * SZ_WIN), S, NP, DM}; pg8::StaticOrder so; so.init(S, NP, G, bx);
            pg8::EpiBf16Act E{PROJ, NP};
            for (int rep_ = 0; rep_ < DUP_INPROJ; ++rep_) pg8::gemm_phase<pg8::EpiBf16Act>(lds, g, so, E);
        }
        SEAM(pb);
        if (IN(pb + 1)) {
#if ATT_SKIP
            for (int rep_ = 0; rep_ < DUP_NORM; ++rep_) { PH_IDS; (void)wave; att_norms(PROJ, (unsigned*)(ws + WS_CTL) + NRM_WORD + 16 * l, lds, gw, NGW, lane); }
#endif
        }
#if ATT_SKIP
        SEAM(pb + 1);
#endif
        if (IN(pb + 2)) {
#ifndef NO_CONV
            for (int rep_ = 0; rep_ < DUP_CS; ++rep_)
            for (int it = vcu; it < S / 32; it += G)
                conv_item(it, PROJ, a.in[I_DW] + l * 31 * 512, a.in[I_DWB] + l * 512, a.in[I_CLG] + l * 512, a.in[I_CLB] + l * 512,
                          (const bf16_t*)(ws + WS_WPW + l * SZ_WPW), a.in[I_PWB] + l * 512, YCAT, lds);
#endif
#ifndef NO_SGU
            for (int rep_ = 0; rep_ < DUP_CS * DUP_SGU; ++rep_)
            for (int it = vcu; it < (S / 128) * 4; it += G)
                sgu_item(it, PROJ, a.in[I_SLG] + l * 512, a.in[I_SLB] + l * 512, (const bf16_t*)(ws + WS_SW + l * SZ_SW), a.in[I_SB] + l * 512, YCAT, lds);
#endif
#ifndef NO_ATT
            for (int rep_ = 0; rep_ < DUP_LIST; ++rep_) att_build_list(lds, CS, (const unsigned*)(ws + WS_CTL) + NRM_WORD + 16 * l);
            for (int rep_ = 0; rep_ < DUP_ATT; ++rep_) {
                const LAS int* Lp = (const LAS int*)(lds + ATL_OFF); const LAS int* jlo = Lp + ATL_JLO; const LAS int* pre = Lp + ATL_PRE; const LAS int* cnt = Lp + ATL_CNT;
                const int T = __builtin_amdgcn_readfirstlane(pre[2048]), q = ((T + 2 * G - 1) / (2 * G)) * 2;
                const int g0 = vcu * q, g1 = (g0 + q < T) ? g0 + q : T;
                if (g0 < g1) {
                    const fox::Bases FB{PROJ, CS, YCAT, (float*)(ws + WS_PART)};
#define RFL(x) __builtin_amdgcn_readfirstlane(x)
#define SEG_AT(s_, R, VALID) do { const int ps_ = RFL(pre[s_]), ps1_ = RFL(pre[(s_) + 1]), len_ = ps1_ - ps_ - SEG_OV; const int qb_ = (s_) & 63, k_ = ((s_) >> 6) & 3; R.hd = (s_) >> 8; const int jl_ = RFL(jlo[R.hd * 64 + qb_]); \
                        int x0_ = (g0 > ps_ ? g0 : ps_) - ps_, x1_ = (g1 < ps1_ ? g1 : ps1_) - ps_; x0_ = x0_ < len_ ? x0_ : len_; x1_ = x1_ < len_ ? x1_ : len_; \
                        R.P0 = qb_ * 256; R.t_lo = slot_lo(jl_, k_) + x0_; R.NT = x1_ - x0_; R.slot = RFL(cnt[s_]) + vcu; VALID = (ps1_ > ps_) && (x1_ > x0_); \
                        R.direct = (x0_ == 0 && x1_ == len_ && (jl_ >> 6) == ((4 * (qb_ + 1) - 1) >> 6)) ? 1 : 0; } while (0)
                    int s = __builtin_amdgcn_readfirstlane(att_find(pre, g0));
                    fox::BlockRef cur; bool ok = false;
                    for (; s < 2048 && RFL(pre[s]) < g1; ++s) { SEG_AT(s, cur, ok); if (ok) break; }
                    if (ok) {
                        fox::Seam sm;
                        fox::fox_prime(FB, cur, (char*)lds_raw, lds, sm);
                        for (;;) {
                            fox::BlockRef nxt = cur; bool okn = false; int sn = s + 1;
                            for (; sn < 2048 && RFL(pre[sn]) < g1; ++sn) { SEG_AT(sn, nxt, okn); if (okn) break; }
                            if (!okn) nxt = cur;
                            fox::fox_block(FB, cur, nxt, (char*)lds_raw, lds, sm);
                            if (!okn) break;
                            cur = nxt; s = sn;
                        }
                    }
                }
            }
#endif
        }
        SEAM(pb + 2);
        if (IN(pb + 3)) {
            if (!COOP) att_build_list(lds, CS, (const unsigned*)(ws + WS_CTL) + NRM_WORD + 16 * l);
            const LAS int* pre = (const LAS int*)(lds + ATL_OFF) + ATL_PRE;
            const int T = pre[2048], q = ((T + 2 * G - 1) / (2 * G)) * 2;
            for (int rep_ = 0; rep_ < DUP_CMB; ++rep_)
            for (int i = vcu; i < 256; i += G) { att_combine(i, q, (const float*)(ws + WS_PART), PROJ, YCAT, lds); att_combine(511 - i, q, (const float*)(ws + WS_PART), PROJ, YCAT, lds); }
        }
        SEAM(pb + 3);
        if (IN(pb + 4)) for (int rep_ = 0; rep_ < DUP_OUT; ++rep_) {
            { pg8::Gemm g{YCAT, (const bf16_t*)(ws + WS_WOUT + l * SZ_WSQ), S, DM, DM}; pg8::StaticOrder so; so.init(S, DM, G, bx); pg8::EpiBf16 E{Y, DM}; pg8::gemm_phase<pg8::EpiBf16>(lds, g, so, E); }
            { pg8::Gemm g{(const bf16_t*)(ws + WS_PB) + (size_t)l * S * PLE, (const bf16_t*)(ws + WS_WPP + l * SZ_WPP), S, DM, PLE}; pg8::StaticOrder so; so.init(S, DM, G, bx); pg8::EpiBf16 E{PBUF, DM}; pg8::gemm_phase<pg8::EpiBf16>(lds, g, so, E); }
        }
        SEAM(pb + 4);
        if (IN(pb + 5)) { PH_IDS; (void)wave; rows_post(hsrc, Y, a.in[I_NPOST] + l * DM, H, XN, gw, NGW, lane); }
        SEAM(pb + 5);
        if (IN(pb + 6)) { pg8::Gemm g{XN, (const bf16_t*)(ws + WS_WPG + l * SZ_WSQ), S, DM, DM}; pg8::StaticOrder so; so.init(S, DM, G, bx); pg8::EpiPle E{H, PBUF, DM}; pg8::gemm_phase<pg8::EpiPle>(lds, g, so, E); }
        SEAM(pb + 6);
        if (l + 1 < DEPTH) {
            if (IN(pb + 7)) for (int rep_ = 0; rep_ < DUP_ROWS; ++rep_) { PH_IDS; (void)wave; rows_pre(H, a.in[I_NPRE] + (l + 1) * DM, a.in[I_WIN] + (size_t)(l + 1) * DM * NIN, a.in[I_BF] + (l + 1) * 8, XN, FL, lds, gw, NGW, lane); }
            SEAM(pb + 7);
        }
    }
#undef IN
#undef SEAM
}

constexpr int N_PHASES = 1 + 8 * DEPTH - 1;

extern "C" void kernel_launch(void* const* d_in, const int* in_sizes, int n_in, void* d_out, int out_size, void* d_ws, size_t ws_size, hipStream_t stream) {
    static int grid = 0;
    if (grid == 0) {
        if (n_in != 19 || out_size != S * DM || ws_size < WS_END) { fprintf(stderr, "kernel_launch: unexpected shapes (n_in %d out %d ws %zu)\n", n_in, out_size, ws_size); grid = -1; return; }
        int dev = 0, cus = 0, per_cu = 0;
        (void)hipGetDevice(&dev); (void)hipDeviceGetAttribute(&cus, hipDeviceAttributeMultiprocessorCount, dev);
        (void)hipFuncSetAttribute((const void*)fwd_kernel<true>, hipFuncAttributeMaxDynamicSharedMemorySize, LDS_BYTES);
        (void)hipFuncSetAttribute((const void*)fwd_kernel<false>, hipFuncAttributeMaxDynamicSharedMemorySize, LDS_BYTES);
        (void)hipOccupancyMaxActiveBlocksPerMultiprocessor(&per_cu, (const void*)fwd_kernel<true>, NTHR, LDS_BYTES);
        if (per_cu < 1) { fprintf(stderr, "kernel_launch: occupancy query says %d blocks/CU\n", per_cu); per_cu = 1; }
        (void)hipGetLastError();
        grid = cus > 0 ? cus : 256;
    }
    if (grid < 0) return;
    KArgs a{};
    for (int i = 0; i < 19; ++i) a.in[i] = (const float*)d_in[i];
    a.out = (float*)d_out; a.ws = (unsigned char*)d_ws;
#if MK_COOP
    (void)hipMemsetAsync((char*)d_ws + WS_CTL, 0, CTL_BYTES, stream);
    a.ph_lo = 0; a.ph_hi = N_PHASES;
    void* args[] = {&a};
    hipError_t e = hipLaunchCooperativeKernel((const void*)fwd_kernel<true>, dim3(grid), dim3(NTHR), args, LDS_BYTES, stream);
    if (e != hipSuccess) fprintf(stderr, "cooperative launch failed: %s (grid %d)\n", hipGetErrorString(e), grid);
#else
    for (int ph = 0; ph < N_PHASES; ++ph) {
        a.ph_lo = ph; a.ph_hi = ph + 1;
        hipLaunchKernelGGL(fwd_kernel<false>, dim3(grid), dim3(NTHR), LDS_BYTES, stream, a);
    }
#endif
}
```
